# Optimizing an MI355X kernel written in HIP

```python
import math
import jax, jax.numpy as jnp
from jax import lax
import numpy as np

D_MODEL = 2048
BATCH = 4
SEQ = 8192
DEPTH = 1

N_ATT_HEADS = 8
ATT_HEAD_DIM = 128
KV_LATENT = 256
IDX_HEADS = 16
IDX_DIM = 64
IDX_TOPK_MAX = 256
Q_BLOCK = 128
N_RET_HEADS = 4
RET_QK_DIM = 128
RET_V_DIM = 256
RET_CHUNK = 128
ROPE_BASE = 10000.0
N_BUCKETS = 32
MAX_DISTANCE = 128
N_MEM = 256
N_CROSS_HEADS = 4
CROSS_HEAD_DIM = 128
N_EXPERTS = 32
TOP_K = 4
D_FF = D_MODEL
SWIGLU_LIMIT = 7.0
SWIGLU_ALPHA = 1.702
MOE_BLOCK = 512
EPS = 1e-6

ATT_WIDTH = N_ATT_HEADS * ATT_HEAD_DIM
RET_WIDTH = N_RET_HEADS * RET_V_DIM
MIX_WIDTH = ATT_WIDTH + RET_WIDTH
SPLITS = (ATT_WIDTH,
          KV_LATENT,
          IDX_HEADS * IDX_DIM,
          IDX_DIM,
          IDX_HEADS,
          N_RET_HEADS * RET_QK_DIM,
          N_RET_HEADS * RET_QK_DIM,
          RET_WIDTH,
          RET_WIDTH)
IN_WIDTH = sum(SPLITS)
SPLIT_POINTS = [int(v) for v in np.cumsum(SPLITS)[:-1]]

kernel_name = "hybrid_dsa_retention_moe_layer"


def rmsnorm(x, g):
    xf = x.astype(jnp.float32)
    y = xf * lax.rsqrt(jnp.mean(xf * xf, axis=-1, keepdims=True) + EPS)
    return (y * g.astype(jnp.float32)).astype(x.dtype)


def t5_bucket(dist):
    n = jnp.maximum(dist, 0)
    max_exact = N_BUCKETS // 2
    nf = jnp.maximum(n, 1).astype(jnp.float32)
    large = max_exact + (jnp.log(nf / max_exact) / math.log(MAX_DISTANCE / max_exact)
                         * (N_BUCKETS - max_exact)).astype(jnp.int32)
    large = jnp.minimum(large, N_BUCKETS - 1)
    return jnp.where(n < max_exact, n, large)


def rotary(x, positions):
    d = x.shape[-1]
    inv = ROPE_BASE ** (-jnp.arange(0, d, 2, dtype=jnp.float32) / d)
    ang = positions.astype(jnp.float32)[..., None] * inv
    cos = jnp.cos(ang)[:, :, None, :]
    sin = jnp.sin(ang)[:, :, None, :]
    xf = x.astype(jnp.float32)
    x1, x2 = xf[..., : d // 2], xf[..., d // 2:]
    return jnp.concatenate([x1 * cos - x2 * sin, x1 * sin + x2 * cos], axis=-1).astype(x.dtype)


def dsa_attention(q, c_kv, q_idx, k_idx, w_idx, positions, w_uk, w_uv, rel_bias):
    B, S = q.shape[0], q.shape[1]
    topk = min(IDX_TOPK_MAX, S // 4)
    nb = S // Q_BLOCK
    q_lat = jnp.einsum('bshd,chd->bshc', q, w_uk) * (ATT_HEAD_DIM ** -0.5)
    w_idx = w_idx * (IDX_HEADS ** -0.5 * IDX_DIM ** -0.5)
    key_pos = jnp.arange(S)

    def blockify(a):
        return a.reshape((B, nb, Q_BLOCK) + a.shape[2:]).swapaxes(0, 1)

    def one_block(args):
        blk, ql, qi, wi, pq = args
        t = blk * Q_BLOCK + jnp.arange(Q_BLOCK)
        causal = key_pos[None, :] <= t[:, None]
        logits = jnp.einsum('bqhd,bsd->bqhs', qi, k_idx)
        score = jnp.einsum('bqh,bqhs->bqs', wi, jax.nn.relu(logits)).astype(jnp.float32)
        score = jnp.where(causal[None], score, -jnp.inf)
        _, sel = lax.top_k(score, topk)
        valid = sel <= t[None, :, None]
        c_sel = jax.vmap(lambda c, i: c[i])(c_kv, sel)
        p_sel = jax.vmap(lambda p, i: p[i])(positions, sel)
        bias = rel_bias[t5_bucket(pq[:, :, None] - p_sel)]
        s = (jnp.einsum('bqhc,bqkc->bqhk', ql, c_sel).astype(jnp.float32)
             + jnp.moveaxis(bias, -1, 2).astype(jnp.float32))
        s = jnp.where(valid[:, :, None, :], s, -jnp.inf)
        p = jax.nn.softmax(s, axis=-1).astype(c_sel.dtype)
        return jnp.einsum('bqhk,bqkc->bqhc', p, c_sel)

    o_lat = lax.map(one_block, (jnp.arange(nb), blockify(q_lat), blockify(q_idx),
                                blockify(w_idx), blockify(positions)))
    o_lat = o_lat.swapaxes(0, 1).reshape(B, S, N_ATT_HEADS, KV_LATENT)
    return jnp.einsum('bshc,chd->bshd', o_lat, w_uv).reshape(B, S, ATT_WIDTH)


def retention(q, k, v, g):
    B, S, H, dk = q.shape
    dv = v.shape[-1]
    n = S // RET_CHUNK
    log_gamma = jnp.log(1.0 - 2.0 ** (-5.0 - jnp.arange(H, dtype=jnp.float32)))
    j = jnp.arange(RET_CHUNK, dtype=jnp.float32)
    diff = j[:, None] - j[None, :]
    inner_decay = jnp.where(diff >= 0, jnp.exp(log_gamma[:, None, None] * jnp.maximum(diff, 0.0)), 0.0)
    cross_decay = jnp.exp(log_gamma[:, None] * (j + 1.0))
    state_decay = jnp.exp(log_gamma[:, None] * (RET_CHUNK - 1.0 - j))
    chunk_decay = jnp.exp(log_gamma * RET_CHUNK)
    k = k * (dk ** -0.5)

    def chunks(a):
        return a.reshape(B, n, RET_CHUNK, H, a.shape[-1]).transpose(1, 0, 3, 2, 4).astype(jnp.float32)

    def step(R, inp):
        qc, kc, vc = inp
        inner = jnp.einsum('bhid,bhjd->bhij', qc, kc) * inner_decay
        o = (jnp.einsum('bhij,bhje->bhie', inner, vc)
             + jnp.einsum('bhid,bhde->bhie', qc, R) * cross_decay[None, :, :, None])
        R = (R * chunk_decay[None, :, None, None]
             + jnp.einsum('bhjd,bhje->bhde', kc * state_decay[None, :, :, None], vc))
        return R, o

    R0 = jnp.zeros((B, H, dk, dv), jnp.float32)
    _, o = lax.scan(step, R0, (chunks(q), chunks(k), chunks(v)))
    o = o.transpose(1, 0, 3, 2, 4).reshape(B, S, H, dv)
    o = o * lax.rsqrt(jnp.mean(o * o, axis=-1, keepdims=True) + EPS)
    return (jax.nn.silu(g.astype(jnp.float32)) * o.reshape(B, S, H * dv)).astype(q.dtype)


def memory_cross_attention(hn, memn, wq, wk, wv, wo):
    B, S, _ = hn.shape
    M = memn.shape[1]
    q = (hn @ wq).reshape(B, S, N_CROSS_HEADS, CROSS_HEAD_DIM)
    k = (memn @ wk).reshape(B, M, N_CROSS_HEADS, CROSS_HEAD_DIM)
    v = (memn @ wv).reshape(B, M, N_CROSS_HEADS, CROSS_HEAD_DIM)
    s = jnp.einsum('bqhd,bmhd->bhqm', q, k).astype(jnp.float32) * (CROSS_HEAD_DIM ** -0.5)
    p = jax.nn.softmax(s, axis=-1).astype(v.dtype)
    o = jnp.einsum('bhqm,bmhd->bqhd', p, v).reshape(B, S, N_CROSS_HEADS * CROSS_HEAD_DIM)
    return o @ wo


def moe(xn, w_router, b_router, w_gu, b_gu, w_down, b_down):
    B, S, D = xn.shape
    xt = xn.reshape(-1, D)
    T = xt.shape[0]
    logits = (xt @ w_router).astype(jnp.float32) + b_router.astype(jnp.float32)
    top_val, top_idx = lax.top_k(logits, TOP_K)
    gates = jax.nn.softmax(top_val, axis=-1)
    A = T * TOP_K
    flat_e = top_idx.reshape(-1)
    flat_tok = jnp.arange(A, dtype=jnp.int32) // TOP_K
    flat_g = gates.reshape(-1)
    order = jnp.argsort(flat_e)
    sorted_e = flat_e[order]
    counts = jnp.zeros((N_EXPERTS,), jnp.int32).at[flat_e].add(1)
    start = jnp.cumsum(counts) - counts
    padded = (counts + MOE_BLOCK - 1) // MOE_BLOCK * MOE_BLOCK
    padded_end = jnp.cumsum(padded)
    padded_start = padded_end - padded
    dest = padded_start[sorted_e] + jnp.arange(A, dtype=jnp.int32) - start[sorted_e]
    n_blocks = -(-A // MOE_BLOCK) + N_EXPERTS
    P = n_blocks * MOE_BLOCK
    slot_tok = jnp.zeros((P,), jnp.int32).at[dest].set(flat_tok[order])
    slot_gate = jnp.zeros((P,), jnp.float32).at[dest].set(flat_g[order])
    block_start = jnp.arange(n_blocks, dtype=jnp.int32) * MOE_BLOCK
    block_expert = jnp.minimum(jnp.searchsorted(padded_end, block_start, side='right'), N_EXPERTS - 1)

    def block_step(acc, inp):
        e, tok, gate = inp
        xb = xt[tok]
        gu = xb @ w_gu[e] + b_gu[e]
        gt = jnp.minimum(gu[:, :D_FF], SWIGLU_LIMIT)
        up = jnp.clip(gu[:, D_FF:], -SWIGLU_LIMIT, SWIGLU_LIMIT)
        hmid = (up + 1.0) * (gt * jax.nn.sigmoid(SWIGLU_ALPHA * gt))
        y = (hmid @ w_down[e] + b_down[e]).astype(jnp.float32)
        return acc.at[tok].add(y * gate[:, None]), None

    acc0 = jnp.zeros((T, D), jnp.float32)
    out, _ = lax.scan(block_step, acc0, (block_expert, slot_tok.reshape(n_blocks, MOE_BLOCK),
                                         slot_gate.reshape(n_blocks, MOE_BLOCK)))
    return out.astype(xn.dtype).reshape(B, S, D)


def setup_inputs(seed: int = 0) -> dict:
    key = jax.random.key(seed)
    ks = jax.random.split(key, 32)
    L = DEPTH

    def nrm(k, shape, scale):
        return jax.random.normal(k, shape, jnp.float32) * scale

    def gain(k, shape):
        return 1.0 + 0.02 * jax.random.normal(k, shape, jnp.float32)

    return {
        "x": nrm(ks[0], (BATCH, SEQ, D_MODEL), 1.0),
        "mem": nrm(ks[1], (BATCH, N_MEM, D_MODEL), 1.0),
        "positions": jnp.broadcast_to(jnp.arange(SEQ, dtype=jnp.int32), (BATCH, SEQ)),
        "norm_mix": gain(ks[2], (L, D_MODEL)),
        "w_in": nrm(ks[3], (L, D_MODEL, IN_WIDTH), D_MODEL ** -0.5),
        "kv_norm": gain(ks[4], (L, KV_LATENT)),
        "idx_k_norm": gain(ks[5], (L, IDX_DIM)),
        "w_uk": nrm(ks[6], (L, KV_LATENT, N_ATT_HEADS, ATT_HEAD_DIM), KV_LATENT ** -0.5),
        "w_uv": nrm(ks[7], (L, KV_LATENT, N_ATT_HEADS, ATT_HEAD_DIM), KV_LATENT ** -0.5),
        "rel_bias": nrm(ks[8], (N_BUCKETS, N_ATT_HEADS), 0.5),
        "w_out": nrm(ks[9], (L, MIX_WIDTH, D_MODEL), MIX_WIDTH ** -0.5),
        "norm_cross": gain(ks[10], (L, D_MODEL)),
        "norm_mem": gain(ks[11], (L, D_MODEL)),
        "w_cq": nrm(ks[12], (L, D_MODEL, N_CROSS_HEADS * CROSS_HEAD_DIM), D_MODEL ** -0.5),
        "w_ck": nrm(ks[13], (L, D_MODEL, N_CROSS_HEADS * CROSS_HEAD_DIM), D_MODEL ** -0.5),
        "w_cv": nrm(ks[14], (L, D_MODEL, N_CROSS_HEADS * CROSS_HEAD_DIM), D_MODEL ** -0.5),
        "w_co": nrm(ks[15], (L, N_CROSS_HEADS * CROSS_HEAD_DIM, D_MODEL), (N_CROSS_HEADS * CROSS_HEAD_DIM) ** -0.5),
        "norm_ffn": gain(ks[16], (L, D_MODEL)),
        "w_router": nrm(ks[17], (L, D_MODEL, N_EXPERTS), D_MODEL ** -0.5),
        "b_router": nrm(ks[18], (L, N_EXPERTS), 0.01),
        "w_gate_up": nrm(ks[19], (L, N_EXPERTS, D_MODEL, 2 * D_FF), D_MODEL ** -0.5),
        "b_gate_up": nrm(ks[20], (L, N_EXPERTS, 2 * D_FF), 0.01),
        "w_down": nrm(ks[21], (L, N_EXPERTS, D_FF, D_MODEL), D_FF ** -0.5),
        "b_down": nrm(ks[22], (L, N_EXPERTS, D_MODEL), 0.01),
        "norm_final": gain(ks[23], (D_MODEL,)),
    }


def reference(x, mem, positions, norm_mix, w_in, kv_norm, idx_k_norm, w_uk, w_uv, rel_bias,
              w_out, norm_cross, norm_mem, w_cq, w_ck, w_cv, w_co, norm_ffn, w_router,
              b_router, w_gate_up, b_gate_up, w_down, b_down, norm_final):
    B, S, _ = x.shape
    h = x
    for l in range(DEPTH):
        hn = rmsnorm(h, norm_mix[l])
        proj = hn @ w_in[l]
        q_att, c_kv, q_idx, k_idx, w_idx, q_ret, k_ret, v_ret, g_ret = jnp.split(proj, SPLIT_POINTS, axis=-1)
        c_kv = rmsnorm(c_kv, kv_norm[l])
        k_idx = rmsnorm(k_idx, idx_k_norm[l])
        y_att = dsa_attention(q_att.reshape(B, S, N_ATT_HEADS, ATT_HEAD_DIM), c_kv,
                              q_idx.reshape(B, S, IDX_HEADS, IDX_DIM), k_idx, w_idx,
                              positions, w_uk[l], w_uv[l], rel_bias)
        q_r = rotary(q_ret.reshape(B, S, N_RET_HEADS, RET_QK_DIM), positions)
        k_r = rotary(k_ret.reshape(B, S, N_RET_HEADS, RET_QK_DIM), positions)
        y_ret = retention(q_r, k_r, v_ret.reshape(B, S, N_RET_HEADS, RET_V_DIM), g_ret)
        h = h + jnp.concatenate([y_att, y_ret], axis=-1) @ w_out[l]
        h = h + memory_cross_attention(rmsnorm(h, norm_cross[l]), rmsnorm(mem, norm_mem[l]),
                                       w_cq[l], w_ck[l], w_cv[l], w_co[l])
        h = h + moe(rmsnorm(h, norm_ffn[l]), w_router[l], b_router[l], w_gate_up[l],
                    b_gate_up[l], w_down[l], b_down[l])
    return rmsnorm(h, norm_final)
```

```cpp
#include <hip/hip_runtime.h>
#include <cstdio>
#include <cstdint>
#include <cmath>

#define LAS __attribute__((address_space(3)))
#define GAS __attribute__((address_space(1)))
typedef unsigned short bf16;
typedef short bf16x8 __attribute__((ext_vector_type(8)));
typedef short s16x4 __attribute__((ext_vector_type(4)));
typedef float f32x4 __attribute__((ext_vector_type(4)));
typedef float f32x2 __attribute__((ext_vector_type(2)));
typedef float f32x16 __attribute__((ext_vector_type(16)));
typedef unsigned u32x4 __attribute__((ext_vector_type(4)));
typedef int i32x4 __attribute__((ext_vector_type(4)));
typedef unsigned u32x2 __attribute__((ext_vector_type(2)));
typedef LAS unsigned char lds_t;

constexpr int BATCH = 4, SEQ = 8192, T = BATCH * SEQ, DM = 2048;
constexpr int NPROJ = 5632;
constexpr int C_QATT = 0, C_CKV = 1024, C_QIDX = 1280, C_KIDX = 2304, C_WIDX = 2368, C_QRET = 2560, C_KRET = 3072, C_VRET = 3584, C_GRET = 4608;
constexpr int IN_WIDTH = 5456;
constexpr int NE = 32, TOPK = 4, DFF = 2048;
constexpr int SLOTS = T * TOPK + NE * 256;
constexpr int NMEM = 256;
constexpr float EPS = 1e-6f;
constexpr float LOG2E = 1.4426950408889634f;

constexpr size_t MiB = 1u << 20;
constexpr size_t WS_CTL = 0, CTL_ZERO_BYTES = 1 * MiB;
constexpr size_t WS_WIN_T = 1 * MiB, WS_WOUT_T = 23 * MiB, WS_WCQ_T = 31 * MiB, WS_WCKV_T = 33 * MiB, WS_WCO_T = 37 * MiB, WS_WUK = 39 * MiB, WS_WUVP = 40 * MiB;
constexpr size_t WS_WGU_T = 41 * MiB, WS_WD_T = 553 * MiB;
constexpr size_t WS_HN = 809 * MiB, WS_MEMN = 937 * MiB, WS_KVC = 941 * MiB, WS_QC = 943 * MiB, WS_OC = 975 * MiB, WS_ROUTE = 1007 * MiB;
constexpr size_t WS_X = 1011 * MiB;
constexpr size_t X_PROJ = WS_X, X_QLAT = WS_X + 352 * MiB, X_SEL = WS_X + 480 * MiB, X_NSEL = WS_X + 512 * MiB, X_KV = WS_X + 513 * MiB, X_RPREV = WS_X + 641 * MiB, X_MIX = WS_X + 705 * MiB, X_ROPE = WS_X + 833 * MiB, X_OLAT = WS_X + 849 * MiB, X_KFRAG = WS_X + 977 * MiB, X_CKV8 = WS_X + 981 * MiB;
constexpr size_t X_ASORT = WS_X, X_HMID = WS_X + 272 * MiB, X_Y = WS_X + 544 * MiB;
constexpr size_t WS_HRES = WS_X + 1088 * MiB;
constexpr size_t WS_END = WS_HRES + 128 * MiB;
constexpr size_t R_TOKE = WS_ROUTE, R_TOKPOS = WS_ROUTE + MiB / 2, R_TOKGATE = WS_ROUTE + MiB, R_TOKSLOT = WS_ROUTE + 3 * MiB / 2, R_SLOTGATE = WS_ROUTE + 2 * MiB, R_SLOTTOK = WS_ROUTE + 3 * MiB;
constexpr size_t WS_SSQ1 = WS_HN, WS_SSQ2 = WS_HN + 2 * MiB, WS_SLOTRSTD = WS_HN + 4 * MiB;
constexpr int CW_TMO = 0, CW_BAR = 4096, CW_ECNT = 16384;

constexpr int IDX_NB = 2;
constexpr int LDS_BYTES = 163840;
constexpr int MISC_OFF = LDS_BYTES - 256;
constexpr int MOE_TAB_OFF = 131072;

constexpr int NWAVES = 8, NTHREADS = 512;

__device__ __forceinline__ unsigned f2bf(float f) { unsigned u = __float_as_uint(f); return (u + 0x7fffu + ((u >> 16) & 1u)) >> 16; }
__device__ __forceinline__ unsigned pk2(float lo, float hi) { typedef __bf16 bf16x2_t_ __attribute__((ext_vector_type(2))); return __builtin_bit_cast(unsigned, __builtin_convertvector((f32x2){lo, hi}, bf16x2_t_)); }
__device__ __forceinline__ float bflo(unsigned w) { return __uint_as_float(w << 16); }
__device__ __forceinline__ float bfhi(unsigned w) { return __uint_as_float(w & 0xffff0000u); }
__device__ __forceinline__ float bf2f(bf16 v) { return __uint_as_float((unsigned)v << 16); }
__device__ __forceinline__ unsigned pk4_fp8(float a, float b, float c, float d) {
    a = __builtin_amdgcn_fmed3f(a, -448.f, 448.f); b = __builtin_amdgcn_fmed3f(b, -448.f, 448.f); c = __builtin_amdgcn_fmed3f(c, -448.f, 448.f); d = __builtin_amdgcn_fmed3f(d, -448.f, 448.f);
    int r = __builtin_amdgcn_cvt_pk_fp8_f32(a, b, 0, false); r = __builtin_amdgcn_cvt_pk_fp8_f32(c, d, r, true); return (unsigned)r; }
__device__ __forceinline__ unsigned pk4_fp8_nc(float a, float b, float c, float d) {
    int r = __builtin_amdgcn_cvt_pk_fp8_f32(a, b, 0, false); r = __builtin_amdgcn_cvt_pk_fp8_f32(c, d, r, true); return (unsigned)r; }
constexpr float Y_S = 16.0f;
constexpr float IDX_QS = 16.0f, IDX_KS = 16.0f;
constexpr float CKV_S = 16.0f;
constexpr float FP8_RS = 8.0f;
constexpr float FP8_XS = 8.0f, FP8_WS = 32.0f, FP8_HS = 4.0f;
#define LDS_WAIT() asm volatile("s_waitcnt lgkmcnt(0)" ::: "memory")
#define VM_WAIT() asm volatile("s_waitcnt vmcnt(0)" ::: "memory")
__device__ __forceinline__ float wave_sum(float v) {
#pragma unroll
    for (int o = 1; o < 64; o <<= 1) v += __shfl_xor(v, o);
    return v;
}
__device__ __forceinline__ s16x4 tr_read(const lds_t* p) {
    typedef short v4i16_t __attribute__((ext_vector_type(4)));
    return __builtin_bit_cast(s16x4, __builtin_amdgcn_ds_read_tr16_b64_v4i16((LAS v4i16_t*)p));
}
__device__ __forceinline__ bf16x8 cat4(s16x4 a, s16x4 b) { bf16x8 r; r[0] = a[0]; r[1] = a[1]; r[2] = a[2]; r[3] = a[3]; r[4] = b[0]; r[5] = b[1]; r[6] = b[2]; r[7] = b[3]; return r; }
__device__ __forceinline__ unsigned off_b(unsigned row, unsigned ch) { return 256u * row + 16u * (ch ^ (((row & 3u) << 2) | ((row >> 2) & 3u))); }
__device__ __forceinline__ unsigned tr_addr16(unsigned lane, unsigned row0, unsigned c, unsigned t) {
    const unsigned g = lane >> 4, q = (lane & 15u) >> 2, p = lane & 3u;
    return off_b(row0 + 8u * g + 4u * t + q, 2u * c + (p >> 1)) + 8u * (p & 1u);
}

#define DECL_AROW(arow) unsigned arow[2][4]; _Pragma("unroll") for (int rb_ = 0; rb_ < 2; ++rb_) _Pragma("unroll") for (int s_ = 0; s_ < 4; ++s_) \
    arow[rb_][s_] = off_b(8u * ((lane & 15) >> 2) + 4u * rb_ + (lane & 3), 4u * s_ + (lane >> 4))
#define DECL_TRB(trb) unsigned trb[2][8]; _Pragma("unroll") for (int t_ = 0; t_ < 2; ++t_) _Pragma("unroll") for (int c_ = 0; c_ < 8; ++c_) trb[t_][c_] = tr_addr16(lane, 0, c_, t_)

namespace pg8 {
constexpr int BM = 256, BK = 64, HALF = 128, HTB = HALF * BK * 2, STAGE_BYTES = 8 * HTB;
__host__ __device__ __forceinline__ int lds_byte(int r, int c) { const int st = (r >> 4) * 2 + (c >> 5), rr = r & 15, cc = c & 31, ob = rr * 64 + cc * 2; return st * 1024 + (ob ^ (((ob >> 9) & 1) << 5)); }
__host__ __device__ __forceinline__ void stage_rc(int b, int& R, int& C) { const int st = b / 1024, sb = b % 1024, swz = sb ^ (((sb >> 9) & 1) << 5); R = (st >> 1) * 16 + swz / 64; C = (st & 1) * 32 + (swz % 64) / 2; }
__host__ __device__ __forceinline__ int perm32(int rho) { const int n = rho >> 4, i = rho & 15; return 8 * (i >> 2) + 4 * n + (i & 3); }

struct Unit { const char* A; const char* B; char* C; const char* R; int e; int pn; int m0; };

struct DenseSched {
    int nM, nN, nwg, G, c;
    const char* A0; const char* B0; char* C0; const char* R0;
    long a_pm, a_pn, b_pn, c_pm, c_pn, r_pm, r_pn; int a_sh;
    __device__ __forceinline__ bool next(int i, Unit& u) const {
        const long L = (long)i * G + c; if (L >= nwg) return false;
        int wgid = (int)L; { const int q = nwg / 8, r = nwg % 8, xcd = wgid % 8, off = wgid / 8; wgid = (xcd < r ? xcd * (q + 1) : r * (q + 1) + (xcd - r) * q) + off; }
        const int nig = 8 * nN, gid = wgid / nig, fm = gid * 8, gsz = (nM - fm) < 8 ? (nM - fm) : 8;
        const int pm = fm + ((wgid % nig) % gsz), pn = (wgid % nig) / gsz;
        u.A = A0 + pm * a_pm + (pn >> a_sh) * a_pn; u.B = B0 + pn * b_pn; u.C = C0 + pm * c_pm + pn * c_pn; u.R = R0 ? R0 + pm * r_pm + pn * r_pn : nullptr; u.e = pm; u.pn = pn; u.m0 = 0; return true;
    }
};
struct MoeSched {
    int NT, nunits, G, c;
    const LAS int* tab;
    const int* rowmap = nullptr; LAS int* idxb = nullptr;
    const char* A0; const char* B0; char* C0; const char* R0;
    long a_mt, b_e, b_pn, c_mt, c_pn, r_mt;
    __device__ __forceinline__ bool next(int i, Unit& u) const {
        const long L = (long)i * G + c; if (L >= nunits) return false;
        const int mt = (int)(L / NT), pn = (int)(L % NT);
        const int e = __builtin_amdgcn_readfirstlane(tab[mt]);
        u.A = A0 + mt * a_mt; u.B = B0 + e * b_e + pn * b_pn; u.C = C0 + mt * c_mt + pn * c_pn; u.R = R0 + mt * r_mt; u.e = e; u.pn = pn; u.m0 = mt * 256; return true;
    }
};

__device__ __forceinline__ unsigned cvt_pk_bf16(float lo, float hi) { unsigned r; asm volatile("v_cvt_pk_bf16_f32 %0, %1, %2" : "=v"(r) : "v"(lo), "v"(hi)); return r; }

struct EpiBf16S {
    static constexpr bool PERM = true;
    int ldc; float scale;
    __device__ __forceinline__ void operator()(const f32x4 (&acc)[2][2][4][2], const Unit& u, int wr, int wc, int fr, int fq) const {
        asm volatile("" : "+v"(fr), "+v"(fq));
        bf16* C = (bf16*)u.C; const int row0 = wr * 64 + fr, col0 = wc * 32 + 8 * fq;
#pragma unroll
        for (int ai = 0; ai < 2; ++ai)
#pragma unroll
            for (int m = 0; m < 4; ++m) { bf16* rowp = C + (size_t)(row0 + ai * HALF + m * 16) * ldc + col0;
#pragma unroll
                for (int bj = 0; bj < 2; ++bj) { const f32x4 v0 = acc[ai][bj][m][0] * scale, v1 = acc[ai][bj][m][1] * scale;
                    u32x4 w; w.x = cvt_pk_bf16(v0[0], v0[1]); w.y = cvt_pk_bf16(v0[2], v0[3]); w.z = cvt_pk_bf16(v1[0], v1[1]); w.w = cvt_pk_bf16(v1[2], v1[3]);
                    *(u32x4*)(rowp + bj * HALF) = w; } }
    }
};
struct EpiBf16RS {
    static constexpr bool PERM = true;
    int ldc; const float* ssq;
    __device__ __forceinline__ void operator()(const f32x4 (&acc)[2][2][4][2], const Unit& u, int wr, int wc, int fr, int fq) const {
        asm volatile("" : "+v"(fr), "+v"(fq));
        bf16* C = (bf16*)u.C; const int row0 = wr * 64 + fr, col0 = wc * 32 + 8 * fq;
        const float* sp = ssq + ((size_t)u.e * 256 + row0) * 8;
        f32x4 pa[8][2];
#pragma unroll
        for (int g = 0; g < 8; ++g) { const float* p = sp + (size_t)((g >> 2) * HALF + (g & 3) * 16) * 8; pa[g][0] = *(const f32x4*)p; pa[g][1] = *(const f32x4*)(p + 4); }
#pragma unroll
        for (int g = 0; g < 8; ++g) { const float s = ((pa[g][0][0] + pa[g][0][1]) + (pa[g][0][2] + pa[g][0][3])) + ((pa[g][1][0] + pa[g][1][1]) + (pa[g][1][2] + pa[g][1][3]));
            const float rstd = rsqrtf(s * (1.0f / DM) + EPS);
            bf16* rowp = C + (size_t)(row0 + (g >> 2) * HALF + (g & 3) * 16) * ldc + col0;
#pragma unroll
            for (int bj = 0; bj < 2; ++bj) { const f32x4 v0 = acc[g >> 2][bj][g & 3][0] * rstd, v1 = acc[g >> 2][bj][g & 3][1] * rstd;
                u32x4 w; w.x = cvt_pk_bf16(v0[0], v0[1]); w.y = cvt_pk_bf16(v0[2], v0[3]); w.z = cvt_pk_bf16(v1[0], v1[1]); w.w = cvt_pk_bf16(v1[2], v1[3]);
                *(u32x4*)(rowp + bj * HALF) = w; } }
    }
};
struct EpiResF32 {
    static constexpr bool PERM = false;
    int ldc;
    __device__ __forceinline__ void operator()(const f32x4 (&acc)[2][2][4][2], const Unit& u, int wr, int wc, int fr, int fq) const {
        asm volatile("" : "+v"(fr), "+v"(fq));
        float* C = (float*)u.C; const float* R = (const float*)u.R; const int row0 = wr * 64 + fr, col0 = wc * 32 + 4 * fq;
#pragma unroll
        for (int ai = 0; ai < 2; ++ai)
#pragma unroll
            for (int m = 0; m < 4; ++m) { const size_t ro = (size_t)(row0 + ai * HALF + m * 16) * ldc + col0;
#pragma unroll
                for (int bj = 0; bj < 2; ++bj)
#pragma unroll
                    for (int n = 0; n < 2; ++n) { const size_t o = ro + bj * HALF + n * 16; *(f32x4*)(C + o) = *(const f32x4*)(R + o) + acc[ai][bj][m][n]; } }
    }
};
struct EpiResBf16 {
    static constexpr bool PERM = true;
    int ldc, ldr; bool rf32;
    unsigned char* h8 = nullptr; const float* gain = nullptr;
    float* ssq = nullptr; LAS float* part = nullptr;
    __device__ __forceinline__ void operator()(const f32x4 (&acc)[2][2][4][2], const Unit& u, int wr, int wc, int fr, int fq) const {
        asm volatile("" : "+v"(fr), "+v"(fq));
        bf16* C = (bf16*)u.C; const int row0 = wr * 64 + fr, col0 = wc * 32 + 8 * fq;
        if (rf32) {
            const float* R = (const float*)u.R + (size_t)row0 * ldr + col0;
            f32x4 rb[8][2][2]; u32x4 w0[2], w1[2];
#define ERB_LOAD(g) do { _Pragma("unroll") for (int bj = 0; bj < 2; ++bj) { const float* rp = R + (size_t)(((g) >> 2) * HALF + ((g) & 3) * 16) * ldr + bj * HALF; rb[g][bj][0] = *(const f32x4*)rp; rb[g][bj][1] = *(const f32x4*)(rp + 4); } } while (0)
#define ERB_PACK(g, WV) do { float sq_ = 0.f; _Pragma("unroll") for (int bj = 0; bj < 2; ++bj) { const f32x4 v0 = acc[(g) >> 2][bj][(g) & 3][0] + rb[g][bj][0], v1 = acc[(g) >> 2][bj][(g) & 3][1] + rb[g][bj][1]; \
                sq_ += ((v0[0] * v0[0] + v0[1] * v0[1]) + (v0[2] * v0[2] + v0[3] * v0[3])) + ((v1[0] * v1[0] + v1[1] * v1[1]) + (v1[2] * v1[2] + v1[3] * v1[3])); \
                WV[bj].x = cvt_pk_bf16(v0[0], v0[1]); WV[bj].y = cvt_pk_bf16(v0[2], v0[3]); WV[bj].z = cvt_pk_bf16(v1[0], v1[1]); WV[bj].w = cvt_pk_bf16(v1[2], v1[3]); } \
                if (ssq) { sq_ += __shfl_xor(sq_, 16); sq_ += __shfl_xor(sq_, 32); if (fq == 0) part[(wr * 64 + fr + ((g) >> 2) * HALF + ((g) & 3) * 16) * 4 + wc] = sq_; } } while (0)
#define ERB_STORE(g, WV) do { bf16* rowp = C + (size_t)(row0 + ((g) >> 2) * HALF + ((g) & 3) * 16) * ldc + col0; *(u32x4*)rowp = WV[0]; *(u32x4*)(rowp + HALF) = WV[1]; } while (0)
            ERB_LOAD(0); ERB_LOAD(1); ERB_LOAD(2); ERB_LOAD(3); ERB_LOAD(4);
            __builtin_amdgcn_sched_barrier(0);
            ERB_PACK(0, w0); ERB_PACK(1, w1);
            __builtin_amdgcn_sched_barrier(0);
            ERB_LOAD(5); ERB_LOAD(6);
            __builtin_amdgcn_sched_barrier(0);
            ERB_STORE(0, w0); ERB_STORE(1, w1);
            ERB_PACK(2, w0);
            __builtin_amdgcn_sched_barrier(0);
            ERB_LOAD(7);
            __builtin_amdgcn_sched_barrier(0);
            ERB_STORE(2, w0);
#pragma unroll
            for (int g = 3; g < 8; ++g) { ERB_PACK(g, w0); ERB_STORE(g, w0); }
            if (ssq) {
                asm volatile("s_waitcnt lgkmcnt(0)" ::: "memory"); __builtin_amdgcn_s_barrier();
                const int t_ = threadIdx.x;
                if (t_ < 256) { const f32x4 p = *(const LAS f32x4*)(part + t_ * 4); ssq[((size_t)u.e * 256 + t_) * 8 + u.pn] = (p[0] + p[1]) + (p[2] + p[3]); }
            }
#undef ERB_LOAD
#undef ERB_PACK
#undef ERB_STORE
        } else {
            const bf16* R = (const bf16*)u.R + (size_t)row0 * ldr + col0;
            u32x4 rw[8][2], oA[2], oB[2]; u32x2 hA[2], hB[2];
#define ERC_LOAD(g) do { _Pragma("unroll") for (int bj = 0; bj < 2; ++bj) rw[g][bj] = *(const u32x4*)(R + (size_t)(((g) >> 2) * HALF + ((g) & 3) * 16) * ldr + bj * HALF); } while (0)
#define ERC_PACK(g, OV, HV) do { float sq_ = 0.f; _Pragma("unroll") for (int bj = 0; bj < 2; ++bj) { const u32x4 w = rw[g][bj]; \
                const f32x4 r0 = (f32x4){bflo(w.x), bfhi(w.x), bflo(w.y), bfhi(w.y)}, r1 = (f32x4){bflo(w.z), bfhi(w.z), bflo(w.w), bfhi(w.w)}; \
                const f32x4 v0 = acc[(g) >> 2][bj][(g) & 3][0] + r0, v1 = acc[(g) >> 2][bj][(g) & 3][1] + r1; \
                OV[bj].x = cvt_pk_bf16(v0[0], v0[1]); OV[bj].y = cvt_pk_bf16(v0[2], v0[3]); OV[bj].z = cvt_pk_bf16(v1[0], v1[1]); OV[bj].w = cvt_pk_bf16(v1[2], v1[3]); \
                if (h8) { sq_ += ((v0[0] * v0[0] + v0[1] * v0[1]) + (v0[2] * v0[2] + v0[3] * v0[3])) + ((v1[0] * v1[0] + v1[1] * v1[1]) + (v1[2] * v1[2] + v1[3] * v1[3])); \
                    const f32x4 q0 = v0 * gq[bj][0], q1 = v1 * gq[bj][1]; HV[bj] = (u32x2){pk4_fp8(q0[0], q0[1], q0[2], q0[3]), pk4_fp8(q1[0], q1[1], q1[2], q1[3])}; } } \
            if (h8) { sq_ += __shfl_xor(sq_, 16); sq_ += __shfl_xor(sq_, 32); if (fq == 0) part[(row0 + ((g) >> 2) * HALF + ((g) & 3) * 16) * 4 + wc] = sq_; } } while (0)
#define ERC_STORE(g, OV, HV) do { const int row = row0 + ((g) >> 2) * HALF + ((g) & 3) * 16; bf16* rowp = C + (size_t)row * ldc + col0; *(u32x4*)rowp = OV[0]; *(u32x4*)(rowp + HALF) = OV[1]; \
            if (h8) { unsigned char* hp = h8 + ((size_t)u.e * 256 + row) * DM + u.pn * 256 + col0; *(u32x2*)hp = HV[0]; *(u32x2*)(hp + HALF) = HV[1]; } } while (0)
            ERC_LOAD(0); ERC_LOAD(1); ERC_LOAD(2); ERC_LOAD(3); ERC_LOAD(4); ERC_LOAD(5);
            f32x4 gq[2][2];
            if (h8) {
#pragma unroll
                for (int bj = 0; bj < 2; ++bj) { const float* gp = gain + u.pn * 256 + col0 + bj * HALF; gq[bj][0] = *(const f32x4*)gp * FP8_RS; gq[bj][1] = *(const f32x4*)(gp + 4) * FP8_RS; }
            }
            __builtin_amdgcn_sched_barrier(0);
            ERC_PACK(0, oA, hA); ERC_PACK(1, oB, hB);
            __builtin_amdgcn_sched_barrier(0);
            ERC_LOAD(6); ERC_LOAD(7);
            __builtin_amdgcn_sched_barrier(0);
            ERC_STORE(0, oA, hA); ERC_STORE(1, oB, hB);
#pragma unroll
            for (int g = 2; g < 8; ++g) { ERC_PACK(g, oA, hA); ERC_STORE(g, oA, hA); }
#undef ERC_LOAD
#undef ERC_PACK
#undef ERC_STORE
            if (h8) {
                asm volatile("s_waitcnt lgkmcnt(0)" ::: "memory"); __builtin_amdgcn_s_barrier();
                const int t_ = threadIdx.x;
                if (t_ < 256) { const f32x4 p = *(const LAS f32x4*)(part + t_ * 4); ssq[((size_t)u.e * 256 + t_) * 8 + u.pn] = (p[0] + p[1]) + (p[2] + p[3]); }
            }
        }
    }
};
struct EpiSwiglu {
    static constexpr bool PERM = true;
    const float* b_gu;
    const float* row_rstd;
    __device__ __forceinline__ void operator()(const f32x4 (&acc)[2][2][4][2], const Unit& u, int wr, int wc, int fr, int fq) const {
        asm volatile("" : "+v"(fr), "+v"(fq));
        const int row0 = wr * 64 + fr, colw = wc * 32 + 8 * fq;
        const float* bp = b_gu + (size_t)u.e * (2 * DFF) + u.pn * 128 + colw;
        constexpr float CS = 1.0f / (FP8_RS * FP8_WS), KE = -1.702f * LOG2E, CK = CS * KE, XMIN = 7.0f * KE, UPS = FP8_HS / KE;
        f32x4 bgk[2], bu[2]; float rs[8];
#pragma unroll
        for (int n = 0; n < 2; ++n) { bgk[n] = *(const f32x4*)(bp + 4 * n) * KE; bu[n] = *(const f32x4*)(bp + DFF + 4 * n); }
#pragma unroll
        for (int g = 0; g < 8; ++g) rs[g] = row_rstd[u.m0 + row0 + (g >> 2) * HALF + (g & 3) * 16];
#pragma unroll
        for (int ai = 0; ai < 2; ++ai)
#pragma unroll
            for (int m = 0; m < 4; ++m) { unsigned char* rowp = (unsigned char*)u.C + (size_t)(row0 + ai * HALF + m * 16) * DFF + colw;
                f32x4 h[2];
                const float ck = rs[ai * 4 + m] * CK, cs = rs[ai * 4 + m] * CS;
#pragma unroll
                for (int n = 0; n < 2; ++n) { f32x4 x = acc[ai][0][m][n] * ck + bgk[n], uu = acc[ai][1][m][n] * cs + bu[n], r;
#pragma unroll
                    for (int j = 0; j < 4; ++j) { x[j] = fmaxf(x[j], XMIN); uu[j] = fminf(fmaxf(uu[j], -7.0f), 7.0f); }
#pragma unroll
                    for (int j = 0; j < 4; ++j) r[j] = __builtin_amdgcn_exp2f(x[j]);
                    r = r + 1.0f;
#pragma unroll
                    for (int j = 0; j < 4; ++j) r[j] = __builtin_amdgcn_rcpf(r[j]);
                    h[n] = (uu * UPS + UPS) * (x * r); }
                *(u32x2*)rowp = (u32x2){pk4_fp8_nc(h[0][0], h[0][1], h[0][2], h[0][3]), pk4_fp8_nc(h[1][0], h[1][1], h[1][2], h[1][3])}; }
    }
};
struct EpiDown {
    static constexpr bool PERM = true;
    const float* b_down;
    __device__ __forceinline__ void operator()(const f32x4 (&acc)[2][2][4][2], const Unit& u, int wr, int wc, int fr, int fq) const {
        asm volatile("" : "+v"(fr), "+v"(fq));
        const float* gate = (const float*)u.R; const int row0 = wr * 64 + fr, colw = wc * 32 + 8 * fq;
        const float* bp = b_down + (size_t)u.e * DM + u.pn * 256 + colw;
        f32x4 bd[2][2];
#pragma unroll
        for (int bj = 0; bj < 2; ++bj)
#pragma unroll
            for (int n = 0; n < 2; ++n) bd[bj][n] = *(const f32x4*)(bp + bj * HALF + 4 * n);
        float gts[8];
#pragma unroll
        for (int g = 0; g < 8; ++g) gts[g] = gate[row0 + (g >> 2) * HALF + (g & 3) * 16];
        __builtin_amdgcn_sched_barrier(0);
#pragma unroll
        for (int ai = 0; ai < 2; ++ai)
#pragma unroll
            for (int m = 0; m < 4; ++m) { const int row = row0 + ai * HALF + m * 16; const float gt = gts[ai * 4 + m] * Y_S; unsigned char* rowp = (unsigned char*)u.C + (size_t)row * DM + colw;
#pragma unroll
                for (int bj = 0; bj < 2; ++bj) { const f32x4 v0 = (acc[ai][bj][m][0] * (1.0f / (FP8_HS * FP8_WS)) + bd[bj][0]) * gt, v1 = (acc[ai][bj][m][1] * (1.0f / (FP8_HS * FP8_WS)) + bd[bj][1]) * gt;
                    *(u32x2*)(rowp + bj * HALF) = (u32x2){pk4_fp8(v0[0], v0[1], v0[2], v0[3]), pk4_fp8(v1[0], v1[1], v1[2], v1[3])}; } }
    }
};

template <class Epi, class Sched, bool ALIGN_EPI, bool FP8 = false, bool GATHER = false>
__device__ __forceinline__ void gemm_phase(lds_t* lds, const int K, const int lda, const int ldb, const Sched& S, const Epi& E) {
    const int tid = threadIdx.x, wid = __builtin_amdgcn_readfirstlane(tid >> 6), lane = tid & 63, wr = wid >> 2, wc = wid & 3, fr = lane & 15, fq = lane >> 4;
    const int nt = K / BK;
    unsigned voffA[2], voffB[2];
#pragma unroll
    for (int i = 0; i < 2; ++i) { int R, C; stage_rc(tid * 16 + i * 8192, R, C); const int Rb = Epi::PERM ? ((R & ~31) + perm32(R & 31)) : R;
        voffA[i] = (unsigned)(R * lda + C) * 2u; voffB[i] = (unsigned)(Rb * ldb + C) * 2u; }
    const size_t kstep = (size_t)(BK * 2);
    const size_t hstepA = GATHER ? (size_t)0 : (size_t)HALF * lda * 2, hstepB = (size_t)HALF * ldb * 2;
    const unsigned ldsw = (unsigned)wid * 1024u;
    const int aoff = lds_byte(wr * 64 + fr, fq * 8), boff = lds_byte(wc * 32 + fr, fq * 8);
    unsigned voffA1[2] = {0u, 0u};
#define PG8_GOFF(dst0, dst1, ibase) do { _Pragma("unroll") for (int _i = 0; _i < 2; ++_i) { int R_, C_; stage_rc(tid * 16 + _i * 8192, R_, C_); \
        dst0[_i] = (unsigned)(ibase)[R_] * (unsigned)(lda * 2) + (unsigned)C_ * 2u; dst1[_i] = (unsigned)(ibase)[R_ + HALF] * (unsigned)(lda * 2) + (unsigned)C_ * 2u; } } while (0)
#define PG8_SA(b, h) (((b) * 2 + (h)) * HTB)
#define PG8_SB(b, h) ((4 + (b) * 2 + (h)) * HTB)
#define PG8_STAGE(bufoff, gbase, voff) do { _Pragma("unroll") for (int _i = 0; _i < 2; ++_i) \
        __builtin_amdgcn_global_load_lds((const unsigned*)((const char*)(gbase) + (voff)[_i]), (LAS unsigned*)(lds + (bufoff) + ldsw + _i * 8192), 16, 0, 0); } while (0)
#define PG8_LD8(off_) __builtin_shufflevector(*(const LAS v4i_t*)(lds + (off_)), *(const LAS v4i_t*)(lds + (off_) + 1024), 0, 1, 2, 3, 4, 5, 6, 7)
#define PG8_LDA(dst, b, h) do { if constexpr (FP8) { _Pragma("unroll") for (int m = 0; m < 4; ++m) dst##8[m] = PG8_LD8(PG8_SA(b, h) + aoff + m * 2048); } \
        else { _Pragma("unroll") for (int m = 0; m < 4; ++m) _Pragma("unroll") for (int k = 0; k < 2; ++k) dst[m][k] = *(const LAS bf16x8*)(lds + PG8_SA(b, h) + aoff + m * 2048 + k * 1024); } } while (0)
#define PG8_LDB(dst, b, h) do { if constexpr (FP8) { _Pragma("unroll") for (int n = 0; n < 2; ++n) dst##8[n] = PG8_LD8(PG8_SB(b, h) + boff + n * 2048); } \
        else { _Pragma("unroll") for (int n = 0; n < 2; ++n) _Pragma("unroll") for (int k = 0; k < 2; ++k) dst[n][k] = *(const LAS bf16x8*)(lds + PG8_SB(b, h) + boff + n * 2048 + k * 1024); } } while (0)
#define PG8_MMA(ai, bj, At, Bt) do { __builtin_amdgcn_s_setprio(1); _Pragma("unroll") for (int m = 0; m < 4; ++m) _Pragma("unroll") for (int n = 0; n < 2; ++n) { \
        if constexpr (FP8) asm volatile("v_mfma_scale_f32_16x16x128_f8f6f4 %0, %1, %2, %0, %3, %3 op_sel_hi:[0,0,0]" : "+v"(acc[ai][bj][m][n]) : "v"(Bt##8[n]), "v"(At##8[m]), "v"(one_scale));   \
        else { _Pragma("unroll") for (int k = 0; k < 2; ++k) acc[ai][bj][m][n] = __builtin_amdgcn_mfma_f32_16x16x32_bf16(Bt[n][k], At[m][k], acc[ai][bj][m][n], 0, 0, 0); } } \
        __builtin_amdgcn_s_setprio(0); } while (0)
#define PG8_WAIT_V(n) asm volatile("s_waitcnt vmcnt(" #n ")" ::: "memory")
#define PG8_WAIT_L(n) asm volatile("s_waitcnt lgkmcnt(" #n ")" ::: "memory")
#define PG8_BAR __builtin_amdgcn_s_barrier()
#define PG8_SCHED __builtin_amdgcn_sched_barrier(0)
    Unit cur, nxt; int ui = 0;
    if (!S.next(0, cur)) return;
    f32x4 acc[2][2][4][2];
#pragma unroll
    for (int a = 0; a < 2; ++a)
#pragma unroll
        for (int b = 0; b < 2; ++b)
#pragma unroll
            for (int m = 0; m < 4; ++m)
#pragma unroll
                for (int n = 0; n < 2; ++n) acc[a][b][m][n] = (f32x4){0.f, 0.f, 0.f, 0.f};
    typedef int v8i_t __attribute__((ext_vector_type(8))); typedef int v4i_t __attribute__((ext_vector_type(4)));
    v8i_t At8[4], B08[2], B18[2]; bf16x8 At[4][2], B0[2][2], B1[2][2];
    const int one_scale = 0x7F7F7F7F;
    const char* cA = cur.A; const char* cB = cur.B;
    if constexpr (GATHER) { const int* rm_ = S.rowmap + cur.m0; PG8_GOFF(voffA, voffA1, rm_); }
#define voffAh1 (GATHER ? voffA1 : voffA)
    PG8_STAGE(PG8_SB(0, 0), cB, voffB); PG8_STAGE(PG8_SB(0, 1), cB + hstepB, voffB); PG8_STAGE(PG8_SA(0, 0), cA, voffA); PG8_STAGE(PG8_SA(0, 1), cA + hstepA, voffAh1);
    if (wr == 1) PG8_BAR;
    PG8_WAIT_V(2); PG8_BAR;
    PG8_STAGE(PG8_SB(1, 0), cB + kstep, voffB); PG8_STAGE(PG8_SA(1, 0), cA + kstep, voffA); PG8_STAGE(PG8_SB(1, 1), cB + hstepB + kstep, voffB);
    PG8_WAIT_V(6); PG8_BAR;
    for (;;) {
        const bool has_next = S.next(ui + 1, nxt);
        const char* nA = has_next ? nxt.A : cA; const char* nB = has_next ? nxt.B : cB;
        if constexpr (GATHER) {
            if (has_next) __builtin_amdgcn_global_load_lds((const unsigned*)(S.rowmap + nxt.m0 + (wid & 3) * 64 + lane), (LAS unsigned*)(S.idxb + ((ui + 1) & 1) * 256 + (wid & 3) * 64), 4, 0, 0);
        }
#pragma unroll 1
        for (int t = 0; t < nt; t += 2) {
            const bool last = (t == nt - 2);
            const char* a1 = cA + (size_t)(t + 1) * kstep;
            const char* a2 = last ? nA : cA + (size_t)(t + 2) * kstep; const char* b2 = last ? nB : cB + (size_t)(t + 2) * kstep;
            const char* a3 = a2 + kstep; const char* b3 = b2 + kstep;
            PG8_LDB(B0, 0, 0); PG8_LDB(B1, 0, 1); PG8_SCHED; PG8_LDA(At, 0, 0); PG8_STAGE(PG8_SA(1, 1), a1 + hstepA, voffAh1);
            if constexpr (GATHER) { if (last && has_next) { const LAS int* ib_ = S.idxb + ((ui + 1) & 1) * 256; PG8_GOFF(voffA, voffA1, ib_); } }
            PG8_WAIT_V(8); PG8_WAIT_L(0); PG8_BAR; PG8_MMA(0, 0, At, B0); PG8_MMA(0, 1, At, B1); PG8_BAR; PG8_SCHED;
            PG8_LDA(At, 0, 1); PG8_STAGE(PG8_SB(0, 0), b2, voffB); PG8_STAGE(PG8_SB(0, 1), b2 + hstepB, voffB); PG8_STAGE(PG8_SA(0, 0), a2, voffA);
            PG8_WAIT_V(8); PG8_WAIT_L(0); PG8_BAR; PG8_MMA(1, 0, At, B0); PG8_MMA(1, 1, At, B1); PG8_BAR; PG8_SCHED;
            PG8_LDB(B0, 1, 0); PG8_LDB(B1, 1, 1); PG8_SCHED; PG8_LDA(At, 1, 0); PG8_STAGE(PG8_SA(0, 1), a2 + hstepA, voffAh1);
            PG8_WAIT_V(8); PG8_WAIT_L(0); PG8_BAR; PG8_MMA(0, 0, At, B0); PG8_MMA(0, 1, At, B1); PG8_BAR; PG8_SCHED;
            PG8_LDA(At, 1, 1); PG8_STAGE(PG8_SB(1, 0), b3, voffB); PG8_STAGE(PG8_SB(1, 1), b3 + hstepB, voffB); PG8_STAGE(PG8_SA(1, 0), a3, voffA);
            PG8_WAIT_V(8); PG8_WAIT_L(0); PG8_BAR; PG8_MMA(1, 0, At, B0); PG8_MMA(1, 1, At, B1); PG8_BAR; PG8_SCHED;
        }
        if constexpr (ALIGN_EPI) { if (wr == 0) PG8_BAR; }
        if constexpr (FP8) { asm volatile("s_nop 15\n\ts_nop 15" ::: "memory"); __builtin_amdgcn_sched_barrier(0); }
        E(acc, cur, wr, wc, fr, fq);
        if (!has_next) break;
#pragma unroll
        for (int a = 0; a < 2; ++a)
#pragma unroll
            for (int b = 0; b < 2; ++b)
#pragma unroll
                for (int m = 0; m < 4; ++m)
#pragma unroll
                    for (int n = 0; n < 2; ++n) acc[a][b][m][n] = (f32x4){0.f, 0.f, 0.f, 0.f};
        cur = nxt; cA = nA; cB = nB; ++ui;
        if constexpr (ALIGN_EPI) { if (wr == 1) PG8_BAR; }
    }
    PG8_WAIT_V(0);
    if constexpr (!ALIGN_EPI) { if (wr == 0) PG8_BAR; }
    PG8_BAR;
#undef PG8_SA
#undef PG8_SB
#undef PG8_STAGE
#undef PG8_LDA
#undef PG8_LD8
#undef PG8_LDB
#undef PG8_MMA
#undef PG8_WAIT_V
#undef PG8_WAIT_L
#undef PG8_BAR
#undef PG8_SCHED
#undef PG8_GOFF
#undef voffAh1
}
}

#define XB_TMO      128
#define XB_XCNT(j)  (256  + 64 * (j))
#define XB_XSUB(j)  (1280 + 64 * (j))
#define XB_XGEN(j)  (2304 + 64 * (j))
#define XB_TOP      3328
#define XB_TOPGEN   3392
#define XCD_BAR_WORDS 3456
#define XB_SPIN_CAP (1u << 22)
__device__ __forceinline__ unsigned xb_ld(unsigned* p)              { return __hip_atomic_load(p, __ATOMIC_RELAXED, __HIP_MEMORY_SCOPE_AGENT); }
__device__ __forceinline__ unsigned xb_add(unsigned* p, unsigned v) { return __hip_atomic_fetch_add(p, v, __ATOMIC_RELAXED, __HIP_MEMORY_SCOPE_AGENT); }
__device__ __forceinline__ unsigned xb_xcc_id() { return (unsigned)__builtin_amdgcn_s_getreg((3 << 11) | 20) & 0xFu; }
#define XB_SPIN(cond, bar) do { unsigned _sp = 0; while (cond) { __builtin_amdgcn_s_sleep(1); \
    if ((++_sp & 255u) == 0u) { if (xb_ld(&(bar)[XB_TMO])) break; if (_sp > XB_SPIN_CAP) { atomicAdd(&(bar)[XB_TMO], 1u); break; } } } } while (0)
struct XcdBarrier { unsigned* bar; unsigned x; volatile LAS unsigned* st; };
__device__ __forceinline__ XcdBarrier xcd_barrier_post(unsigned* bar, volatile LAS unsigned* st) {
    XcdBarrier b; b.bar = bar; b.x = xb_xcc_id(); b.st = st;
    if (threadIdx.x == 0) (void)xb_add(&bar[XB_XCNT(b.x)], 1u);
    return b;
}
__device__ __forceinline__ void xcd_barrier_complete(unsigned* bar, unsigned x, unsigned& nloc, unsigned& nx) {
    const unsigned G = gridDim.x * gridDim.y * gridDim.z;
    unsigned sum, cnt, mine, sp = 0u;
    for (;;) {
        sum = 0u; cnt = 0u; mine = 0u;
#pragma unroll
        for (unsigned j = 0; j < 16; ++j) { const unsigned c = xb_ld(&bar[XB_XCNT(j)]); sum += c; cnt += (c > 0u) ? 1u : 0u; mine = (j == x) ? c : mine; }
        if (sum == G) break;
        __builtin_amdgcn_s_sleep(1);
        if ((++sp & 255u) == 0u) { if (xb_ld(&bar[XB_TMO])) break; if (sp > XB_SPIN_CAP) { atomicAdd(&bar[XB_TMO], 1u); break; } }
    }
    nloc = mine > 0u ? mine : 1u; nx = cnt > 0u ? cnt : 1u;
}
__device__ __forceinline__ void xcd_barrier(const XcdBarrier& b) {
    asm volatile("s_waitcnt vmcnt(0)" ::: "memory");
    __syncthreads();
    if (threadIdx.x == 0) {
        unsigned* bar = b.bar;
        __builtin_amdgcn_s_waitcnt(0);
        unsigned nloc = b.st[0], nx = b.st[1];
        if (nloc == 0u) { xcd_barrier_complete(bar, b.x, nloc, nx); b.st[0] = nloc; b.st[1] = nx; }
        const unsigned old = xb_add(&bar[XB_XSUB(b.x)], 1u);
        const unsigned gen = old / nloc;
        if (old + 1u == (gen + 1u) * nloc) {
            __builtin_amdgcn_fence(__ATOMIC_RELEASE, "agent");
            asm volatile("s_waitcnt vmcnt(0)" ::: "memory");
            const unsigned og = xb_add(&bar[XB_TOP], 1u);
            const unsigned tg = og / nx;
            if (og + 1u == (tg + 1u) * nx) xb_add(&bar[XB_TOPGEN], 1u);
            else XB_SPIN(xb_ld(&bar[XB_TOPGEN]) == tg, bar);
            __builtin_amdgcn_fence(__ATOMIC_ACQUIRE, "agent");
            xb_add(&bar[XB_XGEN(b.x)], 1u);
            asm volatile("s_waitcnt vmcnt(0)" ::: "memory");
        } else {
            XB_SPIN(xb_ld(&bar[XB_XGEN(b.x)]) == gen, bar);
            __builtin_amdgcn_fence(__ATOMIC_ACQUIRE, "agent");
            asm volatile("s_waitcnt vmcnt(0)" ::: "memory");
        }
    }
    __syncthreads();
}

struct Args {
    const float* x; const float* mem; const int* positions; const float* norm_mix; const float* w_in; const float* kv_norm; const float* idx_k_norm;
    const float* w_uk; const float* w_uv; const float* rel_bias; const float* w_out; const float* norm_cross; const float* norm_mem;
    const float* w_cq; const float* w_ck; const float* w_cv; const float* w_co; const float* norm_ffn; const float* w_router; const float* b_router;
    const float* w_gu; const float* b_gu; const float* w_down; const float* b_down; const float* norm_final;
    float* out; unsigned char* ws; int ph_lo, ph_hi; int use_bar, pad;
};

template <class Map>
__device__ __forceinline__ void transpose_item(const float* W, int ldw, bf16* WT, int ldt, int k0, int n0, LAS float* scr, int lane, Map map, const float* rs = nullptr) {
    const int c = lane & 31; const int src = map(n0 + c);
#pragma unroll 8
    for (int i = 0; i < 32; ++i) { const int kk = 2 * i + (lane >> 5); scr[kk * 33 + c] = (src >= 0) ? W[(size_t)(k0 + kk) * ldw + src] * (rs ? rs[k0 + kk] : 1.0f) : 0.f; }
    LDS_WAIT();
    const int ch = lane & 7;
#pragma unroll
    for (int j = 0; j < 4; ++j) { const int n = (lane >> 3) + 8 * j; const LAS float* s = scr + (8 * ch) * 33 + n;
        u32x4 o; o.x = pk2(s[0 * 33], s[1 * 33]); o.y = pk2(s[2 * 33], s[3 * 33]); o.z = pk2(s[4 * 33], s[5 * 33]); o.w = pk2(s[6 * 33], s[7 * 33]);
        *(u32x4*)(WT + (size_t)(n0 + n) * ldt + k0 + 8 * ch) = o; }
    LDS_WAIT();
}
template <class Map>
__device__ __forceinline__ void t8_load(f32x4 (&v)[16], const float* W, int ldw, int k0, int n0, int lane, Map map) {
    const int c4 = (lane & 7) * 4; const int src = map(n0 + c4);
#pragma unroll
    for (int i = 0; i < 16; ++i) v[i] = *(const f32x4*)(W + (size_t)(k0 + 8 * i + (lane >> 3)) * ldw + src);
}
__device__ __forceinline__ void t8_finish(const f32x4 (&v)[16], unsigned char* WT, int ldt, int k0, int n0, LAS float* scr, int lane, float sc) {
    const int c4 = (lane & 7) * 4;
#pragma unroll
    for (int i = 0; i < 16; ++i) { LAS float* d = scr + (8 * i + (lane >> 3)) * 33 + c4; d[0] = v[i].x * sc; d[1] = v[i].y * sc; d[2] = v[i].z * sc; d[3] = v[i].w * sc; }
    LDS_WAIT();
    const int ch = lane & 7;
#pragma unroll
    for (int j = 0; j < 4; ++j) { const int n = (lane >> 3) + 8 * j; const LAS float* s = scr + (16 * ch) * 33 + n;
        u32x4 o; o.x = pk4_fp8(s[0 * 33], s[1 * 33], s[2 * 33], s[3 * 33]); o.y = pk4_fp8(s[4 * 33], s[5 * 33], s[6 * 33], s[7 * 33]);
        o.z = pk4_fp8(s[8 * 33], s[9 * 33], s[10 * 33], s[11 * 33]); o.w = pk4_fp8(s[12 * 33], s[13 * 33], s[14 * 33], s[15 * 33]);
        *(u32x4*)(WT + (size_t)(n0 + n) * ldt + k0 + 16 * ch) = o; }
    LDS_WAIT();
}
__device__ __forceinline__ void rms_row_fp8(const float* xrow, const float* gain, unsigned char* orow, int lane, float sc) {
    const f32x4* xr = (const f32x4*)xrow + lane; const f32x4* gr = (const f32x4*)gain + lane;
    f32x4 v[8]; float s = 0.f;
#pragma unroll
    for (int j = 0; j < 8; ++j) { v[j] = xr[64 * j]; s += (v[j].x * v[j].x + v[j].y * v[j].y) + (v[j].z * v[j].z + v[j].w * v[j].w); }
    const float rstd = rsqrtf(wave_sum(s) * (1.f / DM) + EPS) * sc;
    unsigned* o4 = (unsigned*)orow + lane;
#pragma unroll
    for (int j = 0; j < 8; ++j) { const f32x4 g = gr[64 * j]; o4[64 * j] = pk4_fp8(v[j].x * rstd * g.x, v[j].y * rstd * g.y, v[j].z * rstd * g.z, v[j].w * rstd * g.w); }
}
__device__ __forceinline__ void rms_hrow_bf16(const bf16* hrow, const float* gain, bf16* orow, int lane) {
    const u32x2* xr = (const u32x2*)hrow + lane; const f32x4* gr = (const f32x4*)gain + lane;
    f32x4 v[8]; float s = 0.f;
#pragma unroll
    for (int j = 0; j < 8; ++j) { const u32x2 w = xr[64 * j]; v[j] = (f32x4){bflo(w.x), bfhi(w.x), bflo(w.y), bfhi(w.y)}; s += (v[j].x * v[j].x + v[j].y * v[j].y) + (v[j].z * v[j].z + v[j].w * v[j].w); }
    const float rstd = rsqrtf(wave_sum(s) * (1.f / DM) + EPS);
    u32x2* o8 = (u32x2*)orow + lane;
#pragma unroll
    for (int j = 0; j < 8; ++j) { const f32x4 g = gr[64 * j]; o8[64 * j] = (u32x2){pk2(v[j].x * rstd * g.x, v[j].y * rstd * g.y), pk2(v[j].z * rstd * g.z, v[j].w * rstd * g.w)}; }
}
__device__ __forceinline__ void rms_hrow_fp8(const bf16* hrow, const float* gain, unsigned char* orow, int lane, float sc) {
    const u32x2* xr = (const u32x2*)hrow + lane; const f32x4* gr = (const f32x4*)gain + lane;
    f32x4 v[8]; float s = 0.f;
#pragma unroll
    for (int j = 0; j < 8; ++j) { const u32x2 w = xr[64 * j]; v[j] = (f32x4){bflo(w.x), bfhi(w.x), bflo(w.y), bfhi(w.y)}; s += (v[j].x * v[j].x + v[j].y * v[j].y) + (v[j].z * v[j].z + v[j].w * v[j].w); }
    const float rstd = rsqrtf(wave_sum(s) * (1.f / DM) + EPS) * sc;
    unsigned* o4 = (unsigned*)orow + lane;
#pragma unroll
    for (int j = 0; j < 8; ++j) { const f32x4 g = gr[64 * j]; o4[64 * j] = pk4_fp8(v[j].x * rstd * g.x, v[j].y * rstd * g.y, v[j].z * rstd * g.z, v[j].w * rstd * g.w); }
}
__device__ __forceinline__ void rms_row_bf16(const float* xrow, const float* gain, bf16* orow, int lane) {
    const f32x4* xr = (const f32x4*)xrow + lane; const f32x4* gr = (const f32x4*)gain + lane;
    f32x4 v[8]; float s = 0.f;
#pragma unroll
    for (int j = 0; j < 8; ++j) { v[j] = xr[64 * j]; s += (v[j].x * v[j].x + v[j].y * v[j].y) + (v[j].z * v[j].z + v[j].w * v[j].w); }
    const float rstd = rsqrtf(wave_sum(s) * (1.f / DM) + EPS);
    unsigned long long* o8 = (unsigned long long*)orow + lane;
#pragma unroll
    for (int j = 0; j < 8; ++j) { const f32x4 g = gr[64 * j];
        o8[64 * j] = (unsigned long long)pk2(v[j].x * rstd * g.x, v[j].y * rstd * g.y) | ((unsigned long long)pk2(v[j].z * rstd * g.z, v[j].w * rstd * g.w) << 32); }
}
__device__ __forceinline__ int t5_bucket(int dist) {
    const int n = dist > 0 ? dist : 0;
    if (n < 16) return n;
    const float nf = (float)n;
    int large = 16 + (int)(logf(nf / 16.0f) / 2.0794415416798357f * 16.0f);
    return large < 31 ? large : 31;
}

struct CvtJob { const float* gu_src; const float* dn_src; unsigned char* gu_dst; unsigned char* dn_dst; };
__device__ __forceinline__ CvtJob cvt_job(const float* w_gu, const float* w_down, unsigned char* w_gu8, unsigned char* w_d8, int gwave, int lane) {
    const int e = gwave >> 6, nb = gwave & 63; CvtJob J;
    const int n = 64 * nb + lane;
    const int src = ((n & 255) < 128) ? 128 * (n >> 8) + (n & 127) : DFF + 128 * (n >> 8) + (n & 127);
    J.gu_src = w_gu + (size_t)e * DM * 2 * DFF + src; J.gu_dst = w_gu8 + (size_t)e * 2 * DFF * DM + (size_t)n * DM;
    const int n2 = 64 * (nb >> 1) + lane;
    J.dn_src = w_down + (size_t)e * DFF * DM + (size_t)(1024 * (nb & 1)) * DM + n2; J.dn_dst = w_d8 + (size_t)e * DM * DFF + (size_t)n2 * DFF + 1024 * (nb & 1);
    return J;
}
constexpr int CVT_ITEMS = 192;
#define CVT_ISSUE(R, j_) do { const int jc_ = (j_) < CVT_ITEMS ? (j_) : CVT_ITEMS - 1; const bool gu_ = jc_ < 128; const float* sp_ = gu_ ? J.gu_src + (size_t)(16 * jc_) * (2 * DFF) : J.dn_src + (size_t)(16 * (jc_ - 128)) * DM; \
        const size_t st_ = gu_ ? (size_t)(2 * DFF) : (size_t)DM; _Pragma("unroll") for (int i_ = 0; i_ < 16; ++i_) R[i_] = __builtin_nontemporal_load(sp_ + i_ * st_); } while (0)
#define CVT_DONE(R, j_) do { if ((j_) < CVT_ITEMS) { unsigned char* dp_ = ((j_) < 128) ? J.gu_dst + 16 * (j_) : J.dn_dst + 16 * ((j_) - 128); \
        *(u32x4*)dp_ = (u32x4){pk4_fp8(R[0] * FP8_WS, R[1] * FP8_WS, R[2] * FP8_WS, R[3] * FP8_WS), pk4_fp8(R[4] * FP8_WS, R[5] * FP8_WS, R[6] * FP8_WS, R[7] * FP8_WS), \
                               pk4_fp8(R[8] * FP8_WS, R[9] * FP8_WS, R[10] * FP8_WS, R[11] * FP8_WS), pk4_fp8(R[12] * FP8_WS, R[13] * FP8_WS, R[14] * FP8_WS, R[15] * FP8_WS)}; } } while (0)

__device__ __forceinline__ void idx_phase(const bf16* proj, const unsigned char* kfrag, int* sel, int* nsel, lds_t* lds, const int tid, const int lane, const int wave, const int bx, const int G,
                                          const bool do_cvt, const float* w_gu, const float* w_down, unsigned char* w_gu8, unsigned char* w_d8) {
    typedef __bf16 bf16x2_t __attribute__((ext_vector_type(2))); typedef short s16x2_t __attribute__((ext_vector_type(2)));
    LAS float* Sc = (LAS float*)lds;
    LAS unsigned* hist1 = (LAS unsigned*)(lds + 131072);
    LAS int* mm = (LAS int*)(lds + 155648);
    LAS unsigned* cnts = (LAS unsigned*)(lds + 155648 + 256);
    LAS int* cand = (LAS int*)(lds + 147456);
    for (int i = tid; i < 4096; i += NTHREADS) hist1[i] = 0u;
    if (tid < 4) { cnts[tid] = 0u; mm[2 * tid] = 0x7fffffff; mm[2 * tid + 1] = (int)0x80000000; }
    __syncthreads();
    const int r32 = lane & 31, hi = lane >> 5;
#define F2ORD(f) ({ const int b__ = __float_as_int(f); b__ ^ ((b__ >> 31) & 0x7fffffff); })
    typedef int v8i_t __attribute__((ext_vector_type(8)));
    bf16x8 Af[2][4], Wp[2][2]; v8i_t Af8[2];
#define IDX_FRAGS(gq_) do { const int b_ = (gq_) >> 11, t0_ = ((gq_) & 2047) * 4, rb_ = b_ * SEQ; \
        _Pragma("unroll") for (int rg_ = 0; rg_ < 2; ++rg_) { const int qrow_ = rb_ + t0_ + 2 * rg_ + ((r32 >> 2) & 1), head_ = (r32 & 3) + 4 * (r32 >> 3); \
            const bf16* ap_ = proj + (size_t)qrow_ * NPROJ + C_QIDX + head_ * 64 + 32 * hi; \
            _Pragma("unroll") for (int ks_ = 0; ks_ < 4; ++ks_) Af[rg_][ks_] = *(const bf16x8*)(ap_ + 8 * ks_); \
            const bf16* wp_ = proj + (size_t)(rb_ + t0_ + 2 * rg_ + hi) * NPROJ + C_WIDX; Wp[rg_][0] = *(const bf16x8*)wp_; Wp[rg_][1] = *(const bf16x8*)(wp_ + 8); } \
        } while (0)
    bool havepf = false;
    const CvtJob J = cvt_job(w_gu, w_down, w_gu8, w_d8, bx * NWAVES + wave, lane);
    int cj = do_cvt ? 0 : CVT_ITEMS;
    for (int gq = bx; gq < T / 4; gq += G) {
        const int b = gq >> 11, t0 = (gq & 2047) * 4; const int rowbase = b * SEQ;
        if (t0 < 256) {
            for (int i = tid; i < 1024; i += NTHREADS) { const int q = i >> 8, j = i & 255, t = t0 + q; sel[(size_t)(rowbase + t) * 256 + j] = (j <= t) ? j : 0; }
            if (tid < 4) nsel[rowbase + t0 + tid] = t0 + tid + 1;
            continue;
        }
        if (!havepf) IDX_FRAGS(gq);
#pragma unroll
        for (int rg = 0; rg < 2; ++rg)
#pragma unroll
            for (int ks = 0; ks < 4; ++ks) { const u32x4 w = __builtin_bit_cast(u32x4, Af[rg][ks]);
                Af8[rg][2 * ks] = (int)pk4_fp8(bflo(w.x) * IDX_QS, bfhi(w.x) * IDX_QS, bflo(w.y) * IDX_QS, bfhi(w.y) * IDX_QS); Af8[rg][2 * ks + 1] = (int)pk4_fp8(bflo(w.z) * IDX_QS, bfhi(w.z) * IDX_QS, bflo(w.w) * IDX_QS, bfhi(w.w) * IDX_QS); }
        float mn[2] = {INFINITY, INFINITY}, mx[2] = {-INFINITY, -INFINITY};
        const int ntile = (t0 + 4 + 31) >> 5;
        const unsigned char* kf = kfrag + (size_t)b * 256 * 2048 + lane * 16;
#define IDX_LOAD(B, kt0) do { _Pragma("unroll") for (int j_ = 0; j_ < IDX_NB; ++j_) { int kt_ = (kt0) + 8 * j_; kt_ = kt_ < ntile ? kt_ : ntile - 1; \
            _Pragma("unroll") for (int kp_ = 0; kp_ < 2; ++kp_) B[j_][kp_] = *(const u32x4*)(kf + ((size_t)kt_ * 2 + kp_) * 1024); } } while (0)
#define IDX_DUMP ((155648 + 1024) / 4)
#define IDX_RELU(x) __builtin_amdgcn_fmed3f((x), 0.0f, 3.0e38f)
#define IDX_PK(lo, hi_) __builtin_bit_cast(unsigned, __builtin_convertvector((f32x2){IDX_RELU(lo), IDX_RELU(hi_)}, bf16x2_t))
#define IDX_ONE(Bj, kt_, rg_) do { const int key_ = (kt_) * 32 + r32; f32x16 a0_ = {}; \
                a0_ = __builtin_amdgcn_mfma_scale_f32_32x32x64_f8f6f4(Af8[rg_], __builtin_bit_cast(v8i_t, __builtin_shufflevector(Bj[0], Bj[1], 0, 1, 2, 3, 4, 5, 6, 7)), a0_, 0, 0, 0, 0x7F7F7F7F, 0, 0x7F7F7F7F);     \
                  \
                  \
                float sd_ = 0.f; const u32x4 wa_ = __builtin_bit_cast(u32x4, Wp[rg_][0]), wb_ = __builtin_bit_cast(u32x4, Wp[rg_][1]); \
                const unsigned wv_[8] = {wa_.x, wa_.y, wa_.z, wa_.w, wb_.x, wb_.y, wb_.z, wb_.w}; \
                _Pragma("unroll") for (int i_ = 0; i_ < 8; ++i_) { const s16x2_t p_ = __builtin_elementwise_max(__builtin_bit_cast(s16x2_t, __builtin_convertvector((f32x2){a0_[2 * i_], a0_[2 * i_ + 1]}, bf16x2_t)), (s16x2_t){0, 0}); \
                    sd_ = __builtin_amdgcn_fdot2_f32_bf16(__builtin_bit_cast(bf16x2_t, p_), __builtin_bit_cast(bf16x2_t, wv_[i_]), sd_, false); } \
                const float s0_ = sd_ * 0.03125f; \
                { const bool ok_ = key_ <= t0 + 2 * rg_ + hi;     \
                  Sc[ok_ ? (2 * rg_ + hi) * 8192 + key_ : IDX_DUMP] = s0_; mn[rg_] = fminf(mn[rg_], ok_ ? s0_ : INFINITY); mx[rg_] = fmaxf(mx[rg_], ok_ ? s0_ : -INFINITY); } } while (0)
#define IDX_COMP(B, kt0) do { if ((kt0) + 8 < ntile) { IDX_ONE(B[0], (kt0), 0); IDX_ONE(B[1], (kt0) + 8, 0); IDX_ONE(B[0], (kt0), 1); IDX_ONE(B[1], (kt0) + 8, 1); } \
            else if ((kt0) < ntile) { IDX_ONE(B[0], (kt0), 0); IDX_ONE(B[0], (kt0), 1); } } while (0)
#if defined(PROBE_SCORE2)
        for (int rep_ = 0; rep_ < 2; ++rep_)
#endif
        {
            u32x4 Ba[IDX_NB][2], Bb[IDX_NB][2];
            int kt0 = wave;
            IDX_LOAD(Ba, kt0);
            while (kt0 < ntile) {
                IDX_LOAD(Bb, kt0 + 8 * IDX_NB); IDX_COMP(Ba, kt0); kt0 += 8 * IDX_NB;
                if (kt0 >= ntile) break;
                IDX_LOAD(Ba, kt0 + 8 * IDX_NB); IDX_COMP(Bb, kt0); kt0 += 8 * IDX_NB;
            }
        }
#undef IDX_LOAD
#undef IDX_COMP
#undef IDX_ONE
#undef IDX_PK
#undef IDX_DUMP
#undef IDX_RELU
        { const int gn = gq + G; havepf = (gn < T / 4) && (((gn & 2047) * 4) >= 256); if (havepf) IDX_FRAGS(gn); }
#pragma unroll
        for (int rg = 0; rg < 2; ++rg) {
            __hip_atomic_fetch_min(mm + 2 * (2 * rg + hi), F2ORD(mn[rg]), __ATOMIC_RELAXED, __HIP_MEMORY_SCOPE_WORKGROUP);
            __hip_atomic_fetch_max(mm + 2 * (2 * rg + hi) + 1, F2ORD(mx[rg]), __ATOMIC_RELAXED, __HIP_MEMORY_SCOPE_WORKGROUP);
        }
        float cva[16], cvb[16], cvc[16], cvd[16], cve[16], cvf[16];
        CVT_ISSUE(cva, cj);
        __syncthreads();
        int ln = lane; asm volatile("" : "+v"(ln));
        const int q = wave >> 1, P = wave & 1, nq = t0 + q + 1, nch = (nq + 63) >> 6;
        const int nh = (nch + 1) >> 1, cbeg = P * nh, cend = (cbeg + nh < nch) ? cbeg + nh : nch;
        const int imn_ = mm[2 * q], imx_ = mm[2 * q + 1];
        const float vmin = __int_as_float(imn_ ^ ((imn_ >> 31) & 0x7fffffff)), vmax = __int_as_float(imx_ ^ ((imx_ >> 31) & 0x7fffffff));
        const float range = vmax - vmin; const float kscale = range > 0.f ? 1048576.0f / range : 0.f;
        LAS float* Sq = Sc + q * 8192; LAS int* Kq = (LAS int*)Sq; LAS unsigned* h1q = hist1 + q * 1024;
#define P1_ELEM(v_, s_) do { int k_ = (int)(((v_) - vmin) * kscale); k_ = k_ < 0 ? 0 : k_; k_ = k_ > 1048575 ? 1048575 : k_; Kq[(s_)] = k_; \
            __hip_atomic_fetch_add(h1q + (k_ >> 10), 1u, __ATOMIC_RELAXED, __HIP_MEMORY_SCOPE_WORKGROUP); } while (0)
        const int nfull = nq >> 6;
        const int cfe = cend < nfull ? cend : nfull;
        { int c = cbeg;
          for (; c + 4 <= cfe; c += 4) { float v_[4];
#pragma unroll
              for (int u = 0; u < 4; ++u) v_[u] = Sq[64 * (c + u) + ln];
#pragma unroll
              for (int u = 0; u < 4; ++u) P1_ELEM(v_[u], 64 * (c + u) + ln); }
          for (; c < cfe; ++c) { const float v1_ = Sq[64 * c + ln]; P1_ELEM(v1_, 64 * c + ln); }
          for (; c < cend; ++c) { const int s = 64 * c + ln; if (s < nq) { const float v1_ = Sq[s]; P1_ELEM(v1_, s); } } }
#undef P1_ELEM
        CVT_ISSUE(cvb, cj + 1); CVT_ISSUE(cvc, cj + 2);
        __syncthreads();
        int B1; unsigned cgt1;
        { unsigned h_[16];
          const u32x4 h0 = *(const LAS u32x4*)(h1q + 16 * ln), h1v = *(const LAS u32x4*)(h1q + 16 * ln + 4), h2v = *(const LAS u32x4*)(h1q + 16 * ln + 8), h3v = *(const LAS u32x4*)(h1q + 16 * ln + 12);
          h_[0] = h0.x; h_[1] = h0.y; h_[2] = h0.z; h_[3] = h0.w; h_[4] = h1v.x; h_[5] = h1v.y; h_[6] = h1v.z; h_[7] = h1v.w; h_[8] = h2v.x; h_[9] = h2v.y; h_[10] = h2v.z; h_[11] = h2v.w; h_[12] = h3v.x; h_[13] = h3v.y; h_[14] = h3v.z; h_[15] = h3v.w;
          unsigned tot_ = 0;
#pragma unroll
          for (int j_ = 0; j_ < 16; ++j_) tot_ += h_[j_];
          unsigned suf_ = tot_;
#pragma unroll
          for (int o_ = 1; o_ < 64; o_ <<= 1) { const unsigned t_ = __shfl_down(suf_, o_); if (ln + o_ < 64) suf_ += t_; }
          unsigned cum_ = suf_ - tot_; int bin_ = -1; unsigned cg_ = 0;
#pragma unroll
          for (int j_ = 15; j_ >= 0; --j_) { const bool hit_ = (bin_ < 0) && (cum_ + h_[j_] >= 256u); if (hit_) { bin_ = 16 * ln + j_; cg_ = cum_; } cum_ += h_[j_]; }
          const bool mine_ = (suf_ - tot_) < 256u && 256u <= suf_; const unsigned long long mk_ = __ballot(mine_);
          const int src_ = mk_ ? (int)__builtin_ctzll(mk_) : 0; B1 = __shfl(bin_, src_); cgt1 = (unsigned)__shfl((int)cg_, src_); if (!mk_) { B1 = 0; cgt1 = 0; } }
        CVT_ISSUE(cvd, cj + 3); CVT_ISSUE(cve, cj + 4);
        const unsigned r1 = 256u - cgt1;
        int* outp = sel + (size_t)(rowbase + t0 + q) * 256;
        const unsigned long long ltmask = (1ull << ln) - 1ull, gtmask = ~((2ull << ln) - 1ull);
        unsigned run = 0;
#define P2_CHUNK(K_, s_) do { const int kb_ = (K_) < 0 ? -1 : ((K_) >> 10); const bool em_ = kb_ > B1, cd_ = kb_ == B1; \
            const unsigned long long me_ = __ballot(em_); \
            if (me_) { const unsigned pos_ = P ? (cgt1 - 1u - run - (unsigned)__builtin_popcountll(me_ & gtmask)) : (run + (unsigned)__builtin_popcountll(me_ & ltmask)); \
                if (em_ && pos_ < 256u) outp[pos_] = (s_); run += (unsigned)__builtin_popcountll(me_); } \
            const unsigned long long mc_ = __ballot(cd_); \
            if (mc_) { unsigned base_ = 0; if (ln == 0) base_ = __hip_atomic_fetch_add(cnts + q, (unsigned)__builtin_popcountll(mc_), __ATOMIC_RELAXED, __HIP_MEMORY_SCOPE_WORKGROUP); \
                base_ = __builtin_amdgcn_readfirstlane(base_); const unsigned pos_ = base_ + (unsigned)__builtin_popcountll(mc_ & ltmask); \
                if (cd_ && pos_ < 256u) { cand[(q * 256 + pos_) * 2] = (s_); cand[(q * 256 + pos_) * 2 + 1] = (K_); } } } while (0)
        if (P == 0) {
            int c = cbeg;
            for (; c + 4 <= cend; c += 4) { int k_[4];
#pragma unroll
                for (int u = 0; u < 4; ++u) k_[u] = Kq[64 * (c + u) + ln];
#pragma unroll
                for (int u = 0; u < 4; ++u) P2_CHUNK(k_[u], 64 * (c + u) + ln); }
            for (; c < cend; ++c) { const int k1_ = Kq[64 * c + ln]; P2_CHUNK(k1_, 64 * c + ln); }
        } else {
            int c = cend - 1;
            if (c >= cbeg && c >= nfull) { const int s = 64 * c + ln; const int k1_ = (s < nq) ? Kq[64 * (c & 127) + ln] : -1; P2_CHUNK(k1_, s); --c; }
            for (; c - 3 >= cbeg; c -= 4) { int k_[4];
#pragma unroll
                for (int u = 0; u < 4; ++u) k_[u] = Kq[64 * (c - u) + ln];
#pragma unroll
                for (int u = 0; u < 4; ++u) P2_CHUNK(k_[u], 64 * (c - u) + ln); }
            for (; c >= cbeg; --c) { const int k1_ = Kq[64 * c + ln]; P2_CHUNK(k1_, 64 * c + ln); }
        }
#undef P2_CHUNK
        CVT_ISSUE(cvf, cj + 5);
        __syncthreads();
        if (P == 0) {
            const unsigned nc = cnts[q] < 256u ? cnts[q] : 256u;
            const unsigned take = r1 < nc ? r1 : nc;
            for (int m4 = 0; m4 < 4; ++m4) { const unsigned i = ln + 64 * m4; if (i < nc) { const int myi = cand[(q * 256 + i) * 2], myk = cand[(q * 256 + i) * 2 + 1]; unsigned rank = 0;
                    for (unsigned j = 0; j < nc; ++j) { const int oi = cand[(q * 256 + j) * 2], ok = cand[(q * 256 + j) * 2 + 1]; rank += (ok > myk || (ok == myk && oi < myi)) ? 1u : 0u; }
                    if (rank < take) outp[cgt1 + rank] = myi; } }
            if (ln == 0) nsel[rowbase + t0 + q] = (int)(cgt1 + take);
            LDS_WAIT();
            if (ln == 0) { cnts[q] = 0u; mm[2 * q] = 0x7fffffff; mm[2 * q + 1] = (int)0x80000000; }
        }
        for (int i = tid; i < 4096; i += NTHREADS) hist1[i] = 0u;
        CVT_DONE(cva, cj); CVT_DONE(cvb, cj + 1); CVT_DONE(cvc, cj + 2); CVT_DONE(cvd, cj + 3); CVT_DONE(cve, cj + 4); CVT_DONE(cvf, cj + 5); cj = (cj + 6 < CVT_ITEMS) ? cj + 6 : CVT_ITEMS;
        __syncthreads();
    }
    for (; cj < CVT_ITEMS; cj += 2) { float cva[16], cvb[16]; CVT_ISSUE(cva, cj); CVT_ISSUE(cvb, cj + 1); CVT_DONE(cva, cj); CVT_DONE(cvb, cj + 1); }
}
#undef IDX_FRAGS
#undef F2ORD

__device__ __forceinline__ void sattn_phase(const unsigned char* ckv, const bf16* qlat, bf16* olat, const int* sel, const int* nsel, const int* positions, const float* rel_bias, lds_t* lds, const int tid, const int lane, const int wave, const int gw, const int NGW) {
    typedef __bf16 bf16x2_t __attribute__((ext_vector_type(2)));
    lds_t* buf = lds + wave * 16384;
    LAS unsigned char* bkb = (LAS unsigned char*)(lds + 131072 + wave * 256);
    LAS float* btab = (LAS float*)(lds + 131072 + 2048);
    if (tid < 256) btab[tid] = rel_bias[tid];
    __syncthreads();
    const int head = lane & 15, g = lane >> 4, m15 = lane & 15;
    DECL_TRB(trb);
    unsigned wro[2][4];
    if (gw >= T) return;
    int cntN = nsel[gw], posqN = positions[gw]; int selN[4];
#pragma unroll
    for (int m4 = 0; m4 < 4; ++m4) selN[m4] = sel[(size_t)gw * 256 + lane + 64 * m4];
    (void)wro;
    for (int qi = gw; qi < T; qi += NGW) {
        const int b = qi >> 13; const int rowbase = b * SEQ;
        const int cnt = cntN, posq = posqN; const int nchunk = (cnt + 31) >> 5;
        int selv[4];
#pragma unroll
        for (int m4 = 0; m4 < 4; ++m4) selv[m4] = (lane + 64 * m4 < cnt) ? selN[m4] : 0;
        { const int qn = (qi + NGW < T) ? qi + NGW : qi;
          cntN = nsel[qn]; posqN = positions[qn];
#pragma unroll
          for (int m4 = 0; m4 < 4; ++m4) selN[m4] = sel[(size_t)qn * 256 + lane + 64 * m4]; }
        int pk[4];
#pragma unroll
        for (int m4 = 0; m4 < 4; ++m4) pk[m4] = positions[rowbase + selv[m4]];
#define SA_GATHER(RAW, ch_) do { const int chc_ = (ch_) < nchunk ? (ch_) : nchunk - 1; \
            const int v01_ = (chc_ & 2) ? selv[1] : selv[0], v23_ = (chc_ & 2) ? selv[3] : selv[2]; const int vv_ = (chc_ & 4) ? v23_ : v01_; \
            _Pragma("unroll") for (int rb_ = 0; rb_ < 2; ++rb_) { const int row_ = 8 * (m15 >> 2) + 4 * rb_ + (m15 & 3); const int idx_ = __shfl(vv_, (chc_ & 1) * 32 + row_); \
                const unsigned char* rp_ = ckv + (size_t)(rowbase + idx_) * 256 + 16 * g; \
                _Pragma("unroll") for (int j_ = 0; j_ < 4; ++j_) RAW[rb_][j_] = *(const u32x4*)(rp_ + 64 * j_); } } while (0)
        u32x4 rawA[2][4], rawB[2][4];
        SA_GATHER(rawA, 0);
#pragma unroll
        for (int m4 = 0; m4 < 4; ++m4) bkb[lane + 64 * m4] = (unsigned char)t5_bucket(posq - pk[m4]);
        bf16x8 Qf[8];
#pragma unroll
        for (int s = 0; s < 8; ++s) { Qf[s] = (bf16x8){0, 0, 0, 0, 0, 0, 0, 0}; if (head < 8) Qf[s] = *(const bf16x8*)(qlat + (size_t)qi * 2048 + head * 256 + 64 * (s >> 1) + 16 * g + 8 * (s & 1)); }
        float m_run = -INFINITY, l_run = 0.f;
        f32x4 oacc[16];
#pragma unroll
        for (int c = 0; c < 16; ++c) oacc[c] = (f32x4){0.f, 0.f, 0.f, 0.f};
#define SA_CVT(w_) ((unsigned)__builtin_bit_cast(unsigned, __builtin_amdgcn_cvt_scalef32_pk_bf16_fp8((int)(w_), 1.0f, false))), ((unsigned)__builtin_bit_cast(unsigned, __builtin_amdgcn_cvt_scalef32_pk_bf16_fp8((int)(w_), 1.0f, true)))
#define SA_CHUNK(RAW, ch) do { \
            f32x4 sc[2]; \
            _Pragma("unroll") for (int rb = 0; rb < 2; ++rb) { sc[rb] = (f32x4){0.f, 0.f, 0.f, 0.f}; const unsigned row = 8u * (m15 >> 2) + 4u * rb + (m15 & 3); \
                _Pragma("unroll") for (int j = 0; j < 4; ++j) { \
                    const u32x4 f0 = (u32x4){SA_CVT(RAW[rb][j].x), SA_CVT(RAW[rb][j].y)}, f1 = (u32x4){SA_CVT(RAW[rb][j].z), SA_CVT(RAW[rb][j].w)}; \
                    const unsigned chn = 8u * j + 2u * g; lds_t* im = buf + (chn >> 4) * 8192; \
                    *(LAS u32x4*)(im + off_b(row, chn & 15u)) = f0; *(LAS u32x4*)(im + off_b(row, (chn & 15u) + 1u)) = f1; \
                    sc[rb] = __builtin_amdgcn_mfma_f32_16x16x32_bf16(__builtin_bit_cast(bf16x8, f0), Qf[2 * j], sc[rb], 0, 0, 0); \
                    sc[rb] = __builtin_amdgcn_mfma_f32_16x16x32_bf16(__builtin_bit_cast(bf16x8, f1), Qf[2 * j + 1], sc[rb], 0, 0, 0); } } \
            const unsigned long long bk8 = *(const LAS unsigned long long*)(bkb + (ch) * 32 + 8 * g); \
            float sv[8]; float cmax = -INFINITY; \
            _Pragma("unroll") for (int rb = 0; rb < 2; ++rb) _Pragma("unroll") for (int r = 0; r < 4; ++r) { const int j8 = 4 * rb + r; const int kidx = (ch) * 32 + 8 * g + j8; const unsigned bkt = (unsigned)(bk8 >> (8 * j8)) & 0xffu; \
                    float s = (sc[rb][r] * (1.0f / CKV_S) + btab[(bkt & 31u) * 8 + (head & 7)]) * LOG2E; s = (kidx < cnt) ? s : -INFINITY; sv[j8] = s; cmax = fmaxf(cmax, s); } \
            cmax = fmaxf(cmax, __shfl_xor(cmax, 16)); cmax = fmaxf(cmax, __shfl_xor(cmax, 32)); \
            const float m_new = fmaxf(m_run, cmax); const float m_use = (m_new == -INFINITY) ? 0.f : m_new; \
            const float alpha = __builtin_amdgcn_exp2f(m_run - m_use); \
            float ps = 0.f; float p[8]; \
            _Pragma("unroll") for (int j8 = 0; j8 < 8; ++j8) { p[j8] = __builtin_amdgcn_exp2f(sv[j8] - m_use); ps += p[j8]; } \
            l_run = l_run * alpha + ps; \
            if (!__all(m_new == m_run)) { _Pragma("unroll") for (int c = 0; c < 16; ++c) oacc[c] = oacc[c] * alpha; }     \
            m_run = m_new; \
            const u32x4 pw = (u32x4){pk2(p[0], p[1]), pk2(p[2], p[3]), pk2(p[4], p[5]), pk2(p[6], p[7])}; \
            const bf16x8 Pf = __builtin_bit_cast(bf16x8, pw); \
            asm volatile("s_waitcnt lgkmcnt(0)" ::: "memory"); \
            _Pragma("unroll") for (int c = 0; c < 16; ++c) { const lds_t* im = buf + (c >> 3) * 8192; \
                const bf16x8 A = cat4(tr_read(im + trb[0][c & 7]), tr_read(im + trb[1][c & 7])); \
                oacc[c] = __builtin_amdgcn_mfma_f32_16x16x32_bf16(A, Pf, oacc[c], 0, 0, 0); } \
            asm volatile("s_waitcnt lgkmcnt(0)" ::: "memory"); \
            __builtin_amdgcn_sched_barrier(0); } while (0)
        for (int ch = 0; ch < nchunk; ch += 2) {
            SA_GATHER(rawB, ch + 1);
            SA_CHUNK(rawA, ch);
            if (ch + 1 >= nchunk) break;
            SA_GATHER(rawA, ch + 2);
            SA_CHUNK(rawB, ch + 1);
        }
#undef SA_GATHER
#undef SA_CHUNK
#undef SA_CVT
        float lt = l_run; lt += __shfl_xor(lt, 16); lt += __shfl_xor(lt, 32);
        const float inv = (1.0f / CKV_S) / lt;
        if (head < 8) {
            bf16* op = olat + (size_t)qi * 2048 + head * 256 + 4 * g;
#pragma unroll
            for (int c = 0; c < 16; ++c) { const f32x4 o = oacc[c] * inv; *(u32x2*)(op + 16 * c) = (u32x2){pk2(o[0], o[1]), pk2(o[2], o[3])}; }
        }
    }
}

__global__ void __launch_bounds__(NTHREADS, 2) fwd_kernel(Args a) {
    extern __shared__ __attribute__((aligned(16))) unsigned char lds_raw[];
    lds_t* lds = (lds_t*)lds_raw;
    volatile LAS unsigned* MISC = (volatile LAS unsigned*)(lds + MISC_OFF);
    int tid = threadIdx.x, lane = tid & 63; const int wave = __builtin_amdgcn_readfirstlane(tid >> 6);
    const int G = gridDim.x, bx = blockIdx.x;
    const int gw = bx * NWAVES + wave, NGW = G * NWAVES;
    unsigned char* ws = a.ws;
    unsigned* ctl = (unsigned*)(ws + WS_CTL);
    if (tid < 64) MISC[tid] = 0u;
    __syncthreads();
    XcdBarrier bar; bar.bar = ctl + CW_BAR; bar.x = 0; bar.st = nullptr;
    if (a.use_bar) bar = xcd_barrier_post(ctl + CW_BAR, MISC + 8);
    const int lo = a.ph_lo, hi = a.ph_hi;
#ifndef PH_MASK
#define PH_MASK 0xFFFF
#endif
#define IN(k) (((PH_MASK >> (k)) & 1) && lo <= (k) && (k) < hi)
#define SEAM(k) do { if (IN(k) && IN((k) + 1)) xcd_barrier(bar); asm volatile("" : "+v"(tid)); lane = tid & 63; } while (0)

#define w_inT ((bf16*)(ws + WS_WIN_T))
#define w_outT ((bf16*)(ws + WS_WOUT_T))
#define w_cqT ((bf16*)(ws + WS_WCQ_T))
#define w_ckvT ((bf16*)(ws + WS_WCKV_T))
#define w_coT ((bf16*)(ws + WS_WCO_T))
#define w_ukb ((bf16*)(ws + WS_WUK))
#define w_uvP ((bf16*)(ws + WS_WUVP))
#define w_gu8 (ws + WS_WGU_T)
#define w_d8 (ws + WS_WD_T)
#define hn ((bf16*)(ws + WS_HN))
#define memn ((bf16*)(ws + WS_MEMN))
#define kvc ((bf16*)(ws + WS_KVC))
#define qc ((bf16*)(ws + WS_QC))
#define oc ((bf16*)(ws + WS_OC))
#define proj ((bf16*)(ws + X_PROJ))
#define qlat ((bf16*)(ws + X_QLAT))
#define sel ((int*)(ws + X_SEL))
#define nsel ((int*)(ws + X_NSEL))
#define kvbuf ((float*)(ws + X_KV))
#define rprev ((bf16*)(ws + X_RPREV))
#define mix ((bf16*)(ws + X_MIX))
#define rope ((float*)(ws + X_ROPE))
#define olat ((bf16*)(ws + X_OLAT))
#define kfrag ((unsigned char*)(ws + X_KFRAG))
#define ckv8 (ws + X_CKV8)
#define hres ((bf16*)(ws + WS_HRES))
#define asort (ws + X_ASORT)
#define hmid (ws + X_HMID)
#define ybuf ((bf16*)(ws + X_Y))
#define tok_e ((int*)(ws + R_TOKE))
#define tok_pos ((int*)(ws + R_TOKPOS))
#define tok_gate ((float*)(ws + R_TOKGATE))
#define tok_slot ((int*)(ws + R_TOKSLOT))
#define slot_gate ((float*)(ws + R_SLOTGATE))
#define slot_tok ((int*)(ws + R_SLOTTOK))
#define slot_rstd ((float*)(ws + WS_SLOTRSTD))
#define ssq2 ((const float*)(ws + WS_SSQ2))
    const bool cvt_in_idx = (G == 256);
    if (IN(0)) {
        LAS float* scr = (LAS float*)(lds + wave * 16896);
        for (int it = gw; it < 32 * (NPROJ / 32); it += NGW) { const int kb = it / (NPROJ / 32), nb = it % (NPROJ / 32);
            transpose_item(a.w_in, IN_WIDTH, w_inT, DM, 64 * kb, 32 * nb, scr, lane, [](int n) { return n < 2384 ? n : (n < 2560 ? -1 : n - 176); }); }
        for (int it = gw; it < 32 * 64; it += NGW) { const int kb = it / 64, nb = it % 64; transpose_item(a.w_out, DM, w_outT, DM, 64 * kb, 32 * nb, scr, lane, [](int n) { return n; }); }
        for (int it = gw; it < 32 * 16; it += NGW) { const int kb = it / 16, nb = it % 16; transpose_item(a.w_cq, 512, w_cqT, DM, 64 * kb, 32 * nb, scr, lane, [](int n) { return n; }, a.norm_cross); }
        for (int it = gw; it < 32 * 16; it += NGW) { const int kb = it / 16, nb = it % 16; transpose_item(a.w_ck, 512, w_ckvT, DM, 64 * kb, 32 * nb, scr, lane, [](int n) { return n; }); }
        for (int it = gw; it < 32 * 16; it += NGW) { const int kb = it / 16, nb = it % 16; transpose_item(a.w_cv, 512, w_ckvT + (size_t)512 * DM, DM, 64 * kb, 32 * nb, scr, lane, [](int n) { return n; }); }
        for (int it = gw; it < 8 * 64; it += NGW) { const int kb = it / 64, nb = it % 64; transpose_item(a.w_co, DM, w_coT, 512, 64 * kb, 32 * nb, scr, lane, [](int n) { return n; }); }
        for (int it = gw; it < 4 * 8 * 8; it += NGW) { const int p = it >> 6, kb = (it >> 3) & 7, nb = it & 7;
            const int nhalf = nb >> 2, khalf = kb >> 2;
            const int head = 2 * p + nhalf; const bool nz = (nhalf == khalf);
            transpose_item(a.w_uv + (size_t)(64 * (kb & 3)) * 1024, 1024, w_uvP + (size_t)p * 256 * 512 + 64 * kb, 512, 0, 32 * nb, scr, lane,
                           [=](int n) { return nz ? head * 128 + (n & 127) : -1; }); }
        for (int i = gw * 64 + lane; i < 2048 * 256 / 4; i += NGW * 64) { const int row = i >> 6, k4 = (i & 63) * 4, h = row >> 8, c = row & 255;
            f32x4 v = (f32x4){0.f, 0.f, 0.f, 0.f}; if ((k4 >> 7) == (h & 1)) v = *(const f32x4*)(a.w_uk + (size_t)c * 1024 + h * 128 + (k4 & 127));
            ((u32x2*)w_ukb)[i] = (u32x2){pk2(v.x, v.y), pk2(v.z, v.w)}; }
        if (!cvt_in_idx) { LAS float* scr8 = (LAS float*)(lds + wave * 16896);
          auto gu_map = [](int n) { return ((n & 255) < 128) ? 128 * (n >> 8) + (n & 127) : DFF + 128 * (n >> 8) + (n & 127); };
          auto id_map = [](int n) { return n; };
          constexpr int N_GU = NE * 2048, N_DN = NE * 1024;
#define T8_LOAD(V, it_) do { const int itc_ = (it_) < N_GU + N_DN ? (it_) : N_GU + N_DN - 1; \
              if (itc_ < N_GU) { const int e_ = itc_ >> 11, r_ = itc_ & 2047; t8_load(V, a.w_gu + (size_t)e_ * DM * 2 * DFF, 2 * DFF, 128 * (r_ >> 7), 32 * (r_ & 127), lane, gu_map); } \
              else { const int i2_ = itc_ - N_GU, e_ = i2_ >> 10, r_ = i2_ & 1023; t8_load(V, a.w_down + (size_t)e_ * DFF * DM, DM, 128 * (r_ >> 6), 32 * (r_ & 63), lane, id_map); } } while (0)
#define T8_FIN(V, it_) do { if ((it_) < N_GU) { const int e_ = (it_) >> 11, r_ = (it_) & 2047; t8_finish(V, w_gu8 + (size_t)e_ * 2 * DFF * DM, DM, 128 * (r_ >> 7), 32 * (r_ & 127), scr8, lane, FP8_WS); } \
              else { const int i2_ = (it_) - N_GU, e_ = i2_ >> 10, r_ = i2_ & 1023; t8_finish(V, w_d8 + (size_t)e_ * DM * DFF, DFF, 128 * (r_ >> 6), 32 * (r_ & 63), scr8, lane, FP8_WS); } } while (0)
          f32x4 va[16], vb[16];
          int it = gw;
          if (it < N_GU + N_DN) T8_LOAD(va, it);
          while (it < N_GU + N_DN) {
              T8_LOAD(vb, it + NGW); T8_FIN(va, it); it += NGW;
              if (it >= N_GU + N_DN) break;
              T8_LOAD(va, it + NGW); T8_FIN(vb, it); it += NGW;
          }
#undef T8_LOAD
#undef T8_FIN
        }
        for (int m = gw; m < T; m += NGW) rms_row_bf16(a.x + (size_t)m * DM, a.norm_mix, hn + (size_t)m * DM, lane);
        for (int m = gw; m < BATCH * NMEM; m += NGW) rms_row_bf16(a.mem + (size_t)m * DM, a.norm_mem, memn + (size_t)m * DM, lane);
        for (int i = gw * 64 + lane; i < T * 64; i += NGW * 64) { const int t = i >> 6, f = i & 63;
            const float inv = powf(10000.0f, -(float)(2 * f) / 128.0f); const float ang = (float)a.positions[t] * inv; float sn, cs; sincosf(ang, &sn, &cs);
            ((f32x2*)rope)[i] = (f32x2){cs, sn}; }
    }
    SEAM(0);

    if (IN(1)) {
        { pg8::DenseSched S; S.a_sh = 0; S.r_pm = 0; S.r_pn = 0; S.nM = T / 256; S.nN = NPROJ / 256; S.nwg = S.nM * S.nN; S.G = G; S.c = bx;
          S.A0 = (const char*)hn; S.B0 = (const char*)w_inT; S.C0 = (char*)proj; S.R0 = nullptr;
          S.a_pm = 256L * DM * 2; S.a_pn = 0; S.b_pn = 256L * DM * 2; S.c_pm = 256L * NPROJ * 2; S.c_pn = 512;
          pg8::EpiBf16S E{NPROJ, 1.0f};
          pg8::gemm_phase<pg8::EpiBf16S, pg8::DenseSched, true>(lds, DM, DM, DM, S, E); }
    }
    SEAM(1);

    if (IN(2)) {
        const int nkv = (G > 32) ? 16 : 0;
        if (bx < 16 || nkv == 0) { pg8::DenseSched S; S.a_sh = 0; S.r_pm = 0; S.r_pn = 0; S.nM = 4; S.nN = 4; S.nwg = 16; S.G = G; S.c = bx;
          S.A0 = (const char*)memn; S.B0 = (const char*)w_ckvT; S.C0 = (char*)kvc; S.R0 = nullptr;
          S.a_pm = 256L * DM * 2; S.a_pn = 0; S.b_pn = 256L * DM * 2; S.c_pm = 256L * 1024 * 2; S.c_pn = 512;
          pg8::EpiBf16S E{1024, 1.0f};
          pg8::gemm_phase<pg8::EpiBf16S, pg8::DenseSched, true>(lds, DM, DM, DM, S, E); }
        if (bx >= nkv)
        for (int m = (bx - nkv) * NWAVES + wave; m < T; m += (G - nkv) * NWAVES) {
            bf16* row = proj + (size_t)m * NPROJ;
            { u32x2 w = *((const u32x2*)(row + C_CKV) + lane); float v0 = bflo(w.x), v1 = bfhi(w.x), v2 = bflo(w.y), v3 = bfhi(w.y);
              const float rstd = rsqrtf(wave_sum(v0 * v0 + v1 * v1 + v2 * v2 + v3 * v3) * (1.f / 256.f) + EPS); const f32x4 g = ((const f32x4*)a.kv_norm)[lane];
              *((unsigned*)(ckv8 + (size_t)m * 256) + lane) = pk4_fp8(v0 * rstd * g.x * CKV_S, v1 * rstd * g.y * CKV_S, v2 * rstd * g.z * CKV_S, v3 * rstd * g.w * CKV_S); }
            { const float v = bf2f(row[C_KIDX + lane]); const float rstd = rsqrtf(wave_sum(v * v) * (1.f / 64.f) + EPS);
              const int bb = m >> 13, key = m & 8191, d = lane;
              const float kv = __builtin_amdgcn_fmed3f(v * rstd * a.idx_k_norm[lane] * IDX_KS, -448.0f, 448.0f);
              kfrag[((((size_t)(bb * 256 + (key >> 5)) * 2 + ((d >> 4) & 1)) * 64) + (d >> 5) * 32 + (key & 31)) * 16 + (d & 15)] = (unsigned char)(__builtin_amdgcn_cvt_pk_fp8_f32(kv, kv, 0, false) & 0xff); }
        }
    }
    SEAM(2);

    if (IN(3)) {
        { pg8::DenseSched S; S.a_sh = 0; S.r_pm = 0; S.r_pn = 0; S.nM = T / 256; S.nN = 8; S.nwg = S.nM * 8; S.G = G; S.c = bx;
          S.A0 = (const char*)(proj + C_QATT); S.B0 = (const char*)w_ukb; S.C0 = (char*)qlat; S.R0 = nullptr; S.a_sh = 1;
          S.a_pm = 256L * NPROJ * 2; S.a_pn = 512; S.b_pn = 256L * 256 * 2; S.c_pm = 256L * 2048 * 2; S.c_pn = 512;
          pg8::EpiBf16S E{2048, 0.08838834764831845f};
          pg8::gemm_phase<pg8::EpiBf16S, pg8::DenseSched, true>(lds, 256, NPROJ, 256, S, E); }
        __syncthreads();
        idx_phase(proj, kfrag, sel, nsel, lds, tid, lane, wave, bx, G, cvt_in_idx, a.w_gu, a.w_down, w_gu8, w_d8);
#if defined(PROBE_IDX2)
        __syncthreads(); idx_phase(proj, kfrag, sel, nsel, lds, tid, lane, wave, bx, G, cvt_in_idx, a.w_gu, a.w_down, w_gu8, w_d8);
#endif
        __syncthreads();
        {
            lds_t* kimg = lds;
            lds_t* vimg = lds + 32768;
            DECL_TRB(trb);
            unsigned trv[2][2];
#pragma unroll
            for (int i = 0; i < 2; ++i)
#pragma unroll
                for (int t = 0; t < 2; ++t) trv[i][t] = tr_addr16(lane, 0, (2 * wave + i) & 7, t) + (unsigned)((2 * wave + i) >> 3) * 32768u;
            for (int u = bx; u < 1024; u += G) {
                const int b = u >> 8, h = (u >> 6) & 3, c = u & 63; const int row0 = b * SEQ + c * 128;
                const float lg2 = log2f(1.0f - exp2f(-5.0f - (float)h));
                for (int it = tid; it < 1024; it += NTHREADS) { const int j = it >> 3, i0 = (it & 7) * 8;
                    const bf16* kp = proj + (size_t)(row0 + j) * NPROJ + C_KRET + h * 128 + i0;
                    const u32x4 x1 = *(const u32x4*)kp, x2 = *(const u32x4*)(kp + 64);
                    const float sc = 0.08838834764831845f * exp2f(lg2 * (float)(127 - j));
                    const f32x4* rp = (const f32x4*)(rope + ((size_t)(row0 + j) * 64 + i0) * 2);
                    const unsigned xa[4] = {x1.x, x1.y, x1.z, x1.w}, xb[4] = {x2.x, x2.y, x2.z, x2.w}; unsigned o1[4], o2[4];
#pragma unroll
                    for (int p = 0; p < 4; ++p) { const f32x4 cs = rp[p];
                        const float a0 = bflo(xa[p]), a1 = bfhi(xa[p]), b0 = bflo(xb[p]), b1 = bfhi(xb[p]);
                        o1[p] = pk2((a0 * cs.x - b0 * cs.y) * sc, (a1 * cs.z - b1 * cs.w) * sc); o2[p] = pk2((a0 * cs.y + b0 * cs.x) * sc, (a1 * cs.w + b1 * cs.z) * sc); }
                    *(LAS u32x4*)(kimg + off_b(j, i0 >> 3)) = (u32x4){o1[0], o1[1], o1[2], o1[3]};
                    *(LAS u32x4*)(kimg + off_b(j, 8 + (i0 >> 3))) = (u32x4){o2[0], o2[1], o2[2], o2[3]}; }
                { const char* vb = (const char*)(proj + (size_t)row0 * NPROJ + C_VRET + h * 256);
#pragma unroll
                  for (int i = 0; i < 8; ++i) { const int n = wave * 8 + i; const int j = 4 * (n & 31) + (lane >> 4), ch = (lane & 15) ^ ((((lane >> 4) & 3) << 2) | (n & 3));
                      __builtin_amdgcn_global_load_lds((const unsigned*)(vb + (size_t)j * (NPROJ * 2) + (n >> 5) * 256 + ch * 16), (LAS unsigned*)(vimg + (n >> 5) * 32768 + (n & 31) * 1024), 16, 0, 0); } }
                asm volatile("s_waitcnt vmcnt(0)" ::: "memory");
                __syncthreads();
                f32x4 acc[2][8];
#pragma unroll
                for (int i = 0; i < 2; ++i)
#pragma unroll
                    for (int d = 0; d < 8; ++d) acc[i][d] = (f32x4){0.f, 0.f, 0.f, 0.f};
#pragma unroll
                for (int ks = 0; ks < 4; ++ks) {
                    bf16x8 Av[2], Bk[8];
#pragma unroll
                    for (int i = 0; i < 2; ++i) Av[i] = cat4(tr_read(vimg + trv[i][0] + 8192 * ks), tr_read(vimg + trv[i][1] + 8192 * ks));
#pragma unroll
                    for (int d = 0; d < 8; ++d) Bk[d] = cat4(tr_read(kimg + trb[0][d] + 8192 * ks), tr_read(kimg + trb[1][d] + 8192 * ks));
#pragma unroll
                    for (int i = 0; i < 2; ++i)
#pragma unroll
                        for (int d = 0; d < 8; ++d) acc[i][d] = __builtin_amdgcn_mfma_f32_16x16x32_bf16(Av[i], Bk[d], acc[i][d], 0, 0, 0);
                }
                float* kvo = kvbuf + (size_t)u * 32768;
#pragma unroll
                for (int i = 0; i < 2; ++i)
#pragma unroll
                    for (int d = 0; d < 8; ++d)
#pragma unroll
                        for (int r = 0; r < 4; ++r) kvo[(size_t)(16 * (2 * wave + i) + 4 * (lane >> 4) + r) * 128 + 16 * d + (lane & 15)] = acc[i][d][r];
                __syncthreads();
            }
        }
    }
    SEAM(3);

    if (IN(4)) {
        for (int i = bx * NTHREADS + tid; i < 16 * 32768; i += G * NTHREADS) {
            const int bh = i >> 15, ed = i & 32767, h = bh & 3;
            const float cd = exp2f(128.0f * log2f(1.0f - exp2f(-5.0f - (float)h)));
            float R = 0.f;
            const float* src = kvbuf + (size_t)bh * 64 * 32768 + ed; bf16* dst = rprev + (size_t)bh * 64 * 32768 + ed;
            for (int c0 = 0; c0 < 64; c0 += 8) { float kv[8];
#pragma unroll
                for (int c = 0; c < 8; ++c) kv[c] = src[(size_t)(c0 + c) * 32768];
#pragma unroll
                for (int c = 0; c < 8; ++c) { dst[(size_t)(c0 + c) * 32768] = (bf16)f2bf(R); R = R * cd + kv[c]; } }
        }
        __syncthreads();
        sattn_phase(ckv8, qlat, olat, sel, nsel, a.positions, a.rel_bias, lds, tid, lane, wave, gw, NGW);
#if defined(PROBE_ATT2)
        __syncthreads(); sattn_phase(ckv8, qlat, olat, sel, nsel, a.positions, a.rel_bias, lds, tid, lane, wave, gw, NGW);
#endif
    }
    SEAM(4);

    if (IN(5)) {
        { pg8::DenseSched S; S.a_sh = 0; S.r_pm = 0; S.r_pn = 0; S.nM = T / 256; S.nN = 4; S.nwg = S.nM * 4; S.G = G; S.c = bx;
          S.A0 = (const char*)olat; S.B0 = (const char*)w_uvP; S.C0 = (char*)mix; S.R0 = nullptr;
          S.a_pm = 256L * 2048 * 2; S.a_pn = 1024; S.b_pn = 256L * 512 * 2; S.c_pm = 256L * 2048 * 2; S.c_pn = 512;
          pg8::EpiBf16S E{2048, 1.0f};
          pg8::gemm_phase<pg8::EpiBf16S, pg8::DenseSched, true>(lds, 512, 2048, 512, S, E); }
        __syncthreads();
        {
            lds_t* kimg = lds + 32768; lds_t* vimg = lds + 65536;
            const unsigned keep8 = MISC[8], keep9 = MISC[9];
            __syncthreads();
            const int g = lane >> 4, m15 = lane & 15;
            DECL_AROW(arow); DECL_TRB(trb);
            unsigned rtoff[4];
#pragma unroll
            for (int s = 0; s < 4; ++s) rtoff[s] = off_b((unsigned)m15, 4u * s + (unsigned)g);
            for (int u = bx; u < 1024; u += G) {
                const int b = u >> 8, h = (u >> 6) & 3, c = u & 63; const int row0 = b * SEQ + c * 128;
                const float lg2 = log2f(1.0f - exp2f(-5.0f - (float)h));
                { const char* Rt = (const char*)(rprev + (size_t)u * 32768);
#pragma unroll
                  for (int i = 0; i < 8; ++i) { const int n = wave * 8 + i; const int r = 4 * n + (lane >> 4), ch = (lane & 15) ^ ((((lane >> 4) & 3) << 2) | (n & 3));
                      __builtin_amdgcn_global_load_lds((const unsigned*)(Rt + r * 256 + ch * 16), (LAS unsigned*)((n < 32 ? lds : lds + 131072 - 32768) + n * 1024), 16, 0, 0); } }
                const int il = 16 * wave + m15;
                bf16x8 Qf[4];
                { const bf16* qp = proj + (size_t)(row0 + il) * NPROJ + C_QRET + h * 128 + 8 * g; const float* rp0 = rope + ((size_t)(row0 + il) * 64 + 8 * g) * 2;
#pragma unroll
                  for (int s = 0; s < 2; ++s) { const u32x4 x1 = *(const u32x4*)(qp + 32 * s), x2 = *(const u32x4*)(qp + 32 * s + 64); const f32x4* rp = (const f32x4*)(rp0 + 64 * s);
                      const unsigned xa[4] = {x1.x, x1.y, x1.z, x1.w}, xb[4] = {x2.x, x2.y, x2.z, x2.w}; unsigned o1[4], o2[4];
#pragma unroll
                      for (int p = 0; p < 4; ++p) { const f32x4 cs = rp[p];
                          const float a0 = bflo(xa[p]), a1 = bfhi(xa[p]), b0 = bflo(xb[p]), b1 = bfhi(xb[p]);
                          o1[p] = pk2(a0 * cs.x - b0 * cs.y, a1 * cs.z - b1 * cs.w); o2[p] = pk2(a0 * cs.y + b0 * cs.x, a1 * cs.w + b1 * cs.z); }
                      Qf[s] = __builtin_bit_cast(bf16x8, (u32x4){o1[0], o1[1], o1[2], o1[3]}); Qf[s + 2] = __builtin_bit_cast(bf16x8, (u32x4){o2[0], o2[1], o2[2], o2[3]}); } }
                for (int it = tid; it < 1024; it += NTHREADS) { const int j = (it >> 3) & 127, i0 = (it & 7) * 8;
                    const bf16* kp = proj + (size_t)(row0 + j) * NPROJ + C_KRET + h * 128 + i0;
                    const u32x4 x1 = *(const u32x4*)kp, x2 = *(const u32x4*)(kp + 64);
                    const float sc = 0.08838834764831845f;
                    const f32x4* rp = (const f32x4*)(rope + ((size_t)(row0 + j) * 64 + i0) * 2);
                    const unsigned xa[4] = {x1.x, x1.y, x1.z, x1.w}, xb[4] = {x2.x, x2.y, x2.z, x2.w}; unsigned o1[4], o2[4];
#pragma unroll
                    for (int p = 0; p < 4; ++p) { const f32x4 cs = rp[p];
                        const float a0 = bflo(xa[p]), a1 = bfhi(xa[p]), b0 = bflo(xb[p]), b1 = bfhi(xb[p]);
                        o1[p] = pk2((a0 * cs.x - b0 * cs.y) * sc, (a1 * cs.z - b1 * cs.w) * sc); o2[p] = pk2((a0 * cs.y + b0 * cs.x) * sc, (a1 * cs.w + b1 * cs.z) * sc); }
                    *(LAS u32x4*)(kimg + off_b(j, i0 >> 3)) = (u32x4){o1[0], o1[1], o1[2], o1[3]};
                    *(LAS u32x4*)(kimg + off_b(j, 8 + (i0 >> 3))) = (u32x4){o2[0], o2[1], o2[2], o2[3]}; }
                { const char* vb = (const char*)(proj + (size_t)row0 * NPROJ + C_VRET + h * 256);
#pragma unroll
                  for (int i = 0; i < 8; ++i) { const int n = wave * 8 + i; const int j = 4 * (n & 31) + (lane >> 4), ch = (lane & 15) ^ ((((lane >> 4) & 3) << 2) | (n & 3));
                      __builtin_amdgcn_global_load_lds((const unsigned*)(vb + (size_t)j * (NPROJ * 2) + (n >> 5) * 256 + ch * 16), (LAS unsigned*)(vimg + (n >> 5) * 32768 + (n & 31) * 1024), 16, 0, 0); } }
                asm volatile("s_waitcnt vmcnt(0)" ::: "memory");
                __syncthreads();
                f32x4 oacc[16];
#pragma unroll
                for (int cc = 0; cc < 16; ++cc) oacc[cc] = (f32x4){0.f, 0.f, 0.f, 0.f};
#pragma unroll
                for (int s = 0; s < 4; ++s) { bf16x8 Ar[16];
#pragma unroll
                    for (int cc = 0; cc < 16; ++cc) Ar[cc] = *(const LAS bf16x8*)((cc < 8 ? lds : lds + 131072 - 32768) + 4096 * cc + rtoff[s]);
#pragma unroll
                    for (int cc = 0; cc < 16; ++cc) oacc[cc] = __builtin_amdgcn_mfma_f32_16x16x32_bf16(Ar[cc], Qf[s], oacc[cc], 0, 0, 0);
                    __builtin_amdgcn_sched_barrier(0); }
                const float cdec = exp2f(lg2 * (float)(il + 1));
#pragma unroll
                for (int cc = 0; cc < 16; ++cc) oacc[cc] = oacc[cc] * cdec;
                const bf16* gp = proj + (size_t)(row0 + il) * NPROJ + C_GRET + h * 256 + 4 * g;
                u32x2 gwv[16];
#pragma unroll
                for (int cc = 0; cc < 16; ++cc) gwv[cc] = *(const u32x2*)(gp + 16 * cc);
#pragma unroll 1
                for (int jc = 0; jc <= (wave >> 1); ++jc) {
                    f32x4 sc2[2];
#pragma unroll
                    for (int rb = 0; rb < 2; ++rb) { sc2[rb] = (f32x4){0.f, 0.f, 0.f, 0.f};
#pragma unroll
                        for (int s = 0; s < 4; ++s) { const bf16x8 A = *(const LAS bf16x8*)(kimg + 8192 * jc + arow[rb][s]);
                            sc2[rb] = __builtin_amdgcn_mfma_f32_16x16x32_bf16(A, Qf[s], sc2[rb], 0, 0, 0); } }
                    float p[8];
#pragma unroll
                    for (int rb = 0; rb < 2; ++rb)
#pragma unroll
                        for (int r = 0; r < 4; ++r) { const int j = 32 * jc + 8 * g + 4 * rb + r; const int dd = il - j; p[4 * rb + r] = (dd >= 0) ? sc2[rb][r] * exp2f(lg2 * (float)(dd > 0 ? dd : 0)) : 0.f; }
                    const u32x4 pw = (u32x4){pk2(p[0], p[1]), pk2(p[2], p[3]), pk2(p[4], p[5]), pk2(p[6], p[7])};
                    const bf16x8 Pf = __builtin_bit_cast(bf16x8, pw);
#pragma unroll
                    for (int cc = 0; cc < 16; ++cc) { const lds_t* im = vimg + (cc >> 3) * 32768 + 8192 * jc;
                        const bf16x8 A = cat4(tr_read(im + trb[0][cc & 7]), tr_read(im + trb[1][cc & 7]));
                        oacc[cc] = __builtin_amdgcn_mfma_f32_16x16x32_bf16(A, Pf, oacc[cc], 0, 0, 0); }
                }
                float ss = 0.f;
#pragma unroll
                for (int cc = 0; cc < 16; ++cc) ss += (oacc[cc][0] * oacc[cc][0] + oacc[cc][1] * oacc[cc][1]) + (oacc[cc][2] * oacc[cc][2] + oacc[cc][3] * oacc[cc][3]);
                ss += __shfl_xor(ss, 16); ss += __shfl_xor(ss, 32);
                const float rstd = rsqrtf(ss * (1.f / 256.f) + EPS);
                bf16* op = mix + (size_t)(row0 + il) * 2048 + 1024 + h * 256 + 4 * g;
#pragma unroll
                for (int cc = 0; cc < 16; ++cc) { const u32x2 gw2 = gwv[cc]; const float gv[4] = {bflo(gw2.x), bfhi(gw2.x), bflo(gw2.y), bfhi(gw2.y)}; float o[4];
#pragma unroll
                    for (int r = 0; r < 4; ++r) { const float sg = gv[r] * __builtin_amdgcn_rcpf(1.0f + __builtin_amdgcn_exp2f(-LOG2E * gv[r])); o[r] = sg * oacc[cc][r] * rstd; }
                    *(u32x2*)(op + 16 * cc) = (u32x2){pk2(o[0], o[1]), pk2(o[2], o[3])}; }
                __syncthreads();
            }
            if (tid == 0) { MISC[8] = keep8; MISC[9] = keep9; }
        }
    }
    SEAM(5);

    if (IN(6)) {
        pg8::DenseSched S; S.a_sh = 0; S.r_pm = 0; S.r_pn = 0; S.nM = T / 256; S.nN = 8; S.nwg = S.nM * 8; S.G = G; S.c = bx;
        S.A0 = (const char*)mix; S.B0 = (const char*)w_outT; S.C0 = (char*)hres; S.R0 = (const char*)a.x;
        S.a_pm = 256L * 2048 * 2; S.a_pn = 0; S.b_pn = 256L * 2048 * 2; S.c_pm = 256L * DM * 2; S.c_pn = 512; S.r_pm = 256L * DM * 4; S.r_pn = 1024;
        pg8::EpiResBf16 E{DM, DM, true, nullptr, nullptr, (float*)(ws + WS_SSQ1), (LAS float*)(lds + MOE_TAB_OFF)};
        pg8::gemm_phase<pg8::EpiResBf16, pg8::DenseSched, true>(lds, 2048, 2048, 2048, S, E);
    }
    SEAM(6);


    if (IN(8)) {
        pg8::DenseSched S; S.a_sh = 0; S.r_pm = 0; S.r_pn = 0; S.nM = T / 256; S.nN = 2; S.nwg = S.nM * 2; S.G = G; S.c = bx;
        S.A0 = (const char*)hres; S.B0 = (const char*)w_cqT; S.C0 = (char*)qc; S.R0 = nullptr;
        S.a_pm = 256L * DM * 2; S.a_pn = 0; S.b_pn = 256L * DM * 2; S.c_pm = 256L * 512 * 2; S.c_pn = 512;
        pg8::EpiBf16RS E{512, (const float*)(ws + WS_SSQ1)};
        pg8::gemm_phase<pg8::EpiBf16RS, pg8::DenseSched, true>(lds, DM, DM, DM, S, E);
    }
    SEAM(8);

    if (IN(9)) {
        lds_t* kimg = lds; lds_t* vimg = lds + 65536;
        const int g = lane >> 4, m15 = lane & 15;
        DECL_AROW(arow); DECL_TRB(trb);
        for (int it = bx; it < 256; it += G) {
            const int b = it >> 6, hd = (it >> 4) & 3, slab = it & 15;
            for (int i2 = tid; i2 < 8192; i2 += NTHREADS) { const int which = i2 >> 12, key = (i2 >> 4) & 255, ch = i2 & 15;
                const u32x4 v = *(const u32x4*)(kvc + (size_t)(b * NMEM + key) * 1024 + which * 512 + hd * 128 + ch * 8);
                *(LAS u32x4*)((which ? vimg : kimg) + off_b(key, ch)) = v; }
            __syncthreads();
            bf16x8 Qf[4];
#pragma unroll
            for (int s = 0; s < 4; ++s) Qf[s] = *(const bf16x8*)(qc + (size_t)(b * SEQ + slab * 512 + wave * 16 + m15) * 512 + hd * 128 + 32 * s + 8 * g);
            for (int qt = wave; qt < 32; qt += NWAVES) {
                const int tq = b * SEQ + slab * 512 + qt * 16 + m15;
                f32x4 sc[16];
#pragma unroll
                for (int kb = 0; kb < 16; ++kb) { sc[kb] = (f32x4){0.f, 0.f, 0.f, 0.f};
#pragma unroll
                    for (int s = 0; s < 4; ++s) { const bf16x8 A = *(const LAS bf16x8*)(kimg + 8192 * (kb >> 1) + arow[kb & 1][s]);
                        sc[kb] = __builtin_amdgcn_mfma_f32_16x16x32_bf16(A, Qf[s], sc[kb], 0, 0, 0); }
                    if (kb & 1) __builtin_amdgcn_sched_barrier(0); }
                float mxv = -INFINITY;
                const float scl = 0.08838834764831845f * LOG2E;
#pragma unroll
                for (int kb = 0; kb < 16; ++kb)
#pragma unroll
                    for (int r = 0; r < 4; ++r) { sc[kb][r] *= scl; mxv = fmaxf(mxv, sc[kb][r]); }
                mxv = fmaxf(mxv, __shfl_xor(mxv, 16)); mxv = fmaxf(mxv, __shfl_xor(mxv, 32));
                float ls = 0.f;
#pragma unroll
                for (int kb = 0; kb < 16; ++kb)
#pragma unroll
                    for (int r = 0; r < 4; ++r) { sc[kb][r] = __builtin_amdgcn_exp2f(sc[kb][r] - mxv); ls += sc[kb][r]; }
                ls += __shfl_xor(ls, 16); ls += __shfl_xor(ls, 32);
                f32x4 oacc[8];
#pragma unroll
                for (int cc = 0; cc < 8; ++cc) oacc[cc] = (f32x4){0.f, 0.f, 0.f, 0.f};
#pragma unroll
                for (int kc = 0; kc < 8; ++kc) {
                    const u32x4 pw = (u32x4){pk2(sc[2 * kc][0], sc[2 * kc][1]), pk2(sc[2 * kc][2], sc[2 * kc][3]), pk2(sc[2 * kc + 1][0], sc[2 * kc + 1][1]), pk2(sc[2 * kc + 1][2], sc[2 * kc + 1][3])};
                    const bf16x8 Pf = __builtin_bit_cast(bf16x8, pw);
#pragma unroll
                    for (int cc = 0; cc < 8; ++cc) { const bf16x8 A = cat4(tr_read(vimg + 8192 * kc + trb[0][cc]), tr_read(vimg + 8192 * kc + trb[1][cc]));
                        oacc[cc] = __builtin_amdgcn_mfma_f32_16x16x32_bf16(A, Pf, oacc[cc], 0, 0, 0); }
                    __builtin_amdgcn_sched_barrier(0);
                }
                const float inv = 1.0f / ls;
                { const int qn = (qt + NWAVES < 32) ? qt + NWAVES : qt; const int tn = b * SEQ + slab * 512 + qn * 16 + m15;
#pragma unroll
                  for (int s = 0; s < 4; ++s) Qf[s] = *(const bf16x8*)(qc + (size_t)tn * 512 + hd * 128 + 32 * s + 8 * g); }
                __builtin_amdgcn_sched_barrier(0);
                bf16* op = oc + (size_t)tq * 512 + hd * 128 + 4 * g;
#pragma unroll
                for (int cc = 0; cc < 8; ++cc) { const f32x4 o = oacc[cc] * inv; *(u32x2*)(op + 16 * cc) = (u32x2){pk2(o[0], o[1]), pk2(o[2], o[3])}; }
            }
            __syncthreads();
        }
    }
    SEAM(9);

    if (IN(10)) {
        pg8::DenseSched S; S.a_sh = 0; S.r_pm = 0; S.r_pn = 0; S.nM = T / 256; S.nN = 8; S.nwg = S.nM * 8; S.G = G; S.c = bx;
        S.A0 = (const char*)oc; S.B0 = (const char*)w_coT; S.C0 = (char*)hres; S.R0 = (const char*)hres;
        S.a_pm = 256L * 512 * 2; S.a_pn = 0; S.b_pn = 256L * 512 * 2; S.c_pm = 256L * DM * 2; S.c_pn = 512; S.r_pm = 256L * DM * 2; S.r_pn = 512;
        pg8::EpiResBf16 E{DM, DM, false, asort, a.norm_ffn, (float*)(ws + WS_SSQ2), (LAS float*)(lds + MOE_TAB_OFF)};
        pg8::gemm_phase<pg8::EpiResBf16, pg8::DenseSched, true>(lds, 512, 512, 512, S, E);
    }
    SEAM(10);

    if (IN(11)) {
        LAS float* lt = (LAS float*)(lds + wave * 4608);
        for (int tile = gw; tile < T / 32; tile += NGW) {
            const int t0 = tile * 32; int l11 = lane; asm volatile("" : "+v"(l11));
            const int i = l11 & 31, kk = l11 >> 5;
            const bf16* hrow = hres + (size_t)(t0 + i) * DM + 4 * kk;
            f32x16 acc = {}; float ssq = 0.f;
            for (int m = 0; m < 256; ++m) {
                const u32x2 hw = *(const u32x2*)(hrow + 8 * m); const f32x4 hv = (f32x4){bflo(hw.x), bfhi(hw.x), bflo(hw.y), bfhi(hw.y)}; const f32x4 gv = *(const f32x4*)(a.norm_ffn + 8 * m + 4 * kk);
                ssq += (hv.x * hv.x + hv.y * hv.y) + (hv.z * hv.z + hv.w * hv.w);
                const float* wp = a.w_router + (size_t)(8 * m + 4 * kk) * NE + i;
                const float b0 = wp[0], b1 = wp[NE], b2 = wp[2 * NE], b3 = wp[3 * NE];
                acc = __builtin_amdgcn_mfma_f32_32x32x2f32(hv.x * gv.x, b0, acc, 0, 0, 0);
                acc = __builtin_amdgcn_mfma_f32_32x32x2f32(hv.y * gv.y, b1, acc, 0, 0, 0);
                acc = __builtin_amdgcn_mfma_f32_32x32x2f32(hv.z * gv.z, b2, acc, 0, 0, 0);
                acc = __builtin_amdgcn_mfma_f32_32x32x2f32(hv.w * gv.w, b3, acc, 0, 0, 0);
            }
            ssq += __shfl_xor(ssq, 32);
            const float rstd = rsqrtf(ssq * (1.f / DM) + EPS);
#pragma unroll
            for (int r = 0; r < 16; ++r) lt[((r & 3) + 8 * (r >> 2) + 4 * kk) * 33 + i] = acc[r];
            LDS_WAIT();
            int e_sel[4]; float v_sel[4];
            {
                float lv[32];
#pragma unroll
                for (int e = 0; e < 32; ++e) lv[e] = lt[i * 33 + e] * rstd + a.b_router[e];
#pragma unroll
                for (int k = 0; k < 4; ++k) { float best = -INFINITY; int be = 0;
#pragma unroll
                    for (int e = 0; e < 32; ++e) { const bool tk = lv[e] > best; best = tk ? lv[e] : best; be = tk ? e : be; }
                    e_sel[k] = be; v_sel[k] = best;
#pragma unroll
                    for (int e = 0; e < 32; ++e) lv[e] = (e == be) ? -INFINITY : lv[e]; }
            }
            LDS_WAIT();
            const float mxl = v_sel[0]; float ex[4], sm = 0.f;
#pragma unroll
            for (int k = 0; k < 4; ++k) { ex[k] = __expf(v_sel[k] - mxl); sm += ex[k]; }
            const float rs = 1.0f / sm;
            const unsigned long long ltmask = (1ull << lane) - 1ull;
#pragma unroll
            for (int k = 0; k < 4; ++k) {
                const int myE = (lane < 32) ? e_sel[k] : -1; int mypos = 0;
                for (int ee = 0; ee < NE; ++ee) { const unsigned long long mk = __ballot(myE == ee);
                    if (mk) { unsigned base = 0; if (lane == 0) base = __hip_atomic_fetch_add(ctl + CW_ECNT + 64 * ee, (unsigned)__builtin_popcountll(mk), __ATOMIC_RELAXED, __HIP_MEMORY_SCOPE_AGENT);
                        base = __builtin_amdgcn_readfirstlane(base); if (myE == ee) mypos = (int)(base + (unsigned)__builtin_popcountll(mk & ltmask)); } }
                if (lane < 32) { tok_e[(t0 + i) * 4 + k] = e_sel[k]; tok_pos[(t0 + i) * 4 + k] = mypos; tok_gate[(t0 + i) * 4 + k] = ex[k] * rs; }
            }
        }
    }
    SEAM(11);

    LAS int* moe_tab = (LAS int*)(lds + MOE_TAB_OFF);
    if (IN(12) || IN(13) || IN(14)) {
        if (tid == 0) { int acc_t = 0; for (int e = 0; e < NE; ++e) { const int cnt = (int)__hip_atomic_load(ctl + CW_ECNT + 64 * e, __ATOMIC_RELAXED, __HIP_MEMORY_SCOPE_AGENT); const int nt = (cnt + 255) >> 8;
                moe_tab[e] = acc_t * 256; for (int j = 0; j < nt; ++j) moe_tab[64 + acc_t + j] = e; acc_t += nt; } moe_tab[32] = acc_t; }
        __syncthreads();
    }
    if (IN(12)) {
        for (int e = gw; e < NE; e += NGW) { const int cnt = (int)__hip_atomic_load(ctl + CW_ECNT + 64 * e, __ATOMIC_RELAXED, __HIP_MEMORY_SCOPE_AGENT);
            const int s0 = moe_tab[e] + cnt, s1 = moe_tab[e] + ((cnt + 255) & ~255); for (int s = s0 + lane; s < s1; s += 64) { slot_tok[s] = 0; slot_rstd[s] = 0.f; } }
        for (int t = bx * NTHREADS + tid; t < T; t += G * NTHREADS) {
            const f32x4 p0 = *(const f32x4*)(ssq2 + (size_t)t * 8), p1 = *(const f32x4*)(ssq2 + (size_t)t * 8 + 4);
            const float rstd = rsqrtf((((p0[0] + p0[1]) + (p0[2] + p0[3])) + ((p1[0] + p1[1]) + (p1[2] + p1[3]))) * (1.f / DM) + EPS);
            const i32x4 te = *(const i32x4*)(tok_e + t * 4), tp = *(const i32x4*)(tok_pos + t * 4); const f32x4 tg = *(const f32x4*)(tok_gate + t * 4);
            i32x4 sl;
#pragma unroll
            for (int k = 0; k < 4; ++k) { const int s = moe_tab[te[k]] + tp[k]; sl[k] = s; slot_tok[s] = t; slot_rstd[s] = rstd; slot_gate[s] = tg[k]; }
            *(i32x4*)(tok_slot + t * 4) = sl;
        }
    }
    SEAM(12);

    if (IN(13)) {
        pg8::MoeSched S; S.NT = 16; S.nunits = __builtin_amdgcn_readfirstlane(moe_tab[32]) * 16; S.G = G; S.c = bx; S.tab = moe_tab + 64;
        S.A0 = (const char*)asort; S.B0 = (const char*)w_gu8; S.C0 = (char*)hmid; S.R0 = (const char*)slot_gate;
        S.rowmap = slot_tok; S.idxb = moe_tab + 1024;
        S.a_mt = 0; S.b_e = (long)2 * DFF * DM; S.b_pn = 256L * DM; S.c_mt = 256L * DFF; S.c_pn = 128; S.r_mt = 1024;
        pg8::EpiSwiglu E{a.b_gu, slot_rstd};
        pg8::gemm_phase<pg8::EpiSwiglu, pg8::MoeSched, true, true, true>(lds, DM / 2, DM / 2, DM / 2, S, E);
    }
    SEAM(13);

    if (IN(14)) {
        pg8::MoeSched S; S.NT = 8; S.nunits = __builtin_amdgcn_readfirstlane(moe_tab[32]) * 8; S.G = G; S.c = bx; S.tab = moe_tab + 64;
        S.A0 = (const char*)hmid; S.B0 = (const char*)w_d8; S.C0 = (char*)ybuf; S.R0 = (const char*)slot_gate;
        S.a_mt = 256L * DFF; S.b_e = (long)DM * DFF; S.b_pn = 256L * DFF; S.c_mt = 256L * DM; S.c_pn = 256; S.r_mt = 1024;
        pg8::EpiDown E{a.b_down};
        pg8::gemm_phase<pg8::EpiDown, pg8::MoeSched, true, true>(lds, DFF / 2, DFF / 2, DFF / 2, S, E);
    }
    SEAM(14);

    if (IN(15)) {
        for (int m = gw; m < T; m += NGW) {
            float* row = a.out + (size_t)m * DM;
            const u32x2* xr = (const u32x2*)(hres + (size_t)m * DM) + lane; const f32x4* gr = (const f32x4*)a.norm_final + lane;
            const int s0 = tok_slot[m * 4 + 0], s1 = tok_slot[m * 4 + 1], s2 = tok_slot[m * 4 + 2], s3 = tok_slot[m * 4 + 3];
            const unsigned char* yb = (const unsigned char*)ybuf;
            const unsigned* y0 = (const unsigned*)(yb + (size_t)s0 * DM) + lane; const unsigned* y1 = (const unsigned*)(yb + (size_t)s1 * DM) + lane;
            const unsigned* y2 = (const unsigned*)(yb + (size_t)s2 * DM) + lane; const unsigned* y3 = (const unsigned*)(yb + (size_t)s3 * DM) + lane;
            f32x4 v[8]; float s = 0.f;
#pragma unroll
            for (int j = 0; j < 8; ++j) { { const u32x2 hw = xr[64 * j]; v[j] = (f32x4){bflo(hw.x), bfhi(hw.x), bflo(hw.y), bfhi(hw.y)}; }
                const unsigned a0 = y0[64 * j], a1 = y1[64 * j], a2 = y2[64 * j], a3 = y3[64 * j];
                const f32x2 l0 = __builtin_amdgcn_cvt_pk_f32_fp8((int)a0, false), h0 = __builtin_amdgcn_cvt_pk_f32_fp8((int)a0, true), l1 = __builtin_amdgcn_cvt_pk_f32_fp8((int)a1, false), h1 = __builtin_amdgcn_cvt_pk_f32_fp8((int)a1, true);
                const f32x2 l2 = __builtin_amdgcn_cvt_pk_f32_fp8((int)a2, false), h2 = __builtin_amdgcn_cvt_pk_f32_fp8((int)a2, true), l3 = __builtin_amdgcn_cvt_pk_f32_fp8((int)a3, false), h3 = __builtin_amdgcn_cvt_pk_f32_fp8((int)a3, true);
                v[j].x += ((l0.x + l1.x) + (l2.x + l3.x)) * (1.0f / Y_S); v[j].y += ((l0.y + l1.y) + (l2.y + l3.y)) * (1.0f / Y_S);
                v[j].z += ((h0.x + h1.x) + (h2.x + h3.x)) * (1.0f / Y_S); v[j].w += ((h0.y + h1.y) + (h2.y + h3.y)) * (1.0f / Y_S);
                s += (v[j].x * v[j].x + v[j].y * v[j].y) + (v[j].z * v[j].z + v[j].w * v[j].w); }
            const float rstd = rsqrtf(wave_sum(s) * (1.f / DM) + EPS);
            f32x4* orow = (f32x4*)row + lane;
#pragma unroll
            for (int j = 0; j < 8; ++j) { const f32x4 g = gr[64 * j]; orow[64 * j] = (f32x4){v[j].x * rstd * g.x, v[j].y * rstd * g.y, v[j].z * rstd * g.z, v[j].w * rstd * g.w}; }
        }
    }
#undef w_inT
#undef w_outT
#undef w_cqT
#undef w_ckvT
#undef w_coT
#undef w_ukb
#undef w_uvP
#undef w_gu8
#undef w_d8
#undef hn
#undef memn
#undef kvc
#undef qc
#undef oc
#undef proj
#undef qlat
#undef sel
#undef nsel
#undef kvbuf
#undef rprev
#undef mix
#undef rope
#undef olat
#undef kfrag
#undef ckv8
#undef hres
#undef asort
#undef hmid
#undef ybuf
#undef tok_e
#undef tok_pos
#undef tok_gate
#undef tok_slot
#undef slot_gate
#undef slot_tok
#undef slot_rstd
#undef ssq2
#undef IN
#undef SEAM
}

constexpr int N_PHASES = 16;
#ifndef MK_ONE_LAUNCH
#define MK_ONE_LAUNCH 1
#endif
#ifndef REP_MASK
#define REP_MASK 0
#endif
extern "C" void kernel_launch(void* const* d_in, const int* in_sizes, int n_in, void* d_out, int out_size, void* d_ws, size_t ws_size, hipStream_t stream) {
    static int grid = 0;
    if (grid == 0) {
        if (n_in != 25 || out_size != T * DM || ws_size < WS_END) { fprintf(stderr, "kernel_launch: unexpected shapes: n_in %d out %d ws %zu (need %zu)\n", n_in, out_size, ws_size, (size_t)WS_END); grid = -1; return; }
        int dev = 0, cus = 0;
        if (hipGetDevice(&dev) != hipSuccess || hipDeviceGetAttribute(&cus, hipDeviceAttributeMultiprocessorCount, dev) != hipSuccess) { grid = -1; return; }
        if (hipFuncSetAttribute((const void*)fwd_kernel, hipFuncAttributeMaxDynamicSharedMemorySize, LDS_BYTES) != hipSuccess) { fprintf(stderr, "kernel_launch: hipFuncSetAttribute failed\n"); grid = -1; return; }
        int per_cu = 0;
        if (hipOccupancyMaxActiveBlocksPerMultiprocessor(&per_cu, (const void*)fwd_kernel, NTHREADS, LDS_BYTES) != hipSuccess || per_cu < 1) { fprintf(stderr, "kernel_launch: occupancy query says %d\n", per_cu); }
        (void)hipGetLastError();
        grid = cus;
    }
    if (grid < 0) return;
    (void)hipMemsetAsync((char*)d_ws + WS_CTL, 0, CTL_ZERO_BYTES, stream);
    Args a{};
    a.x = (const float*)d_in[0]; a.mem = (const float*)d_in[1]; a.positions = (const int*)d_in[2]; a.norm_mix = (const float*)d_in[3]; a.w_in = (const float*)d_in[4];
    a.kv_norm = (const float*)d_in[5]; a.idx_k_norm = (const float*)d_in[6]; a.w_uk = (const float*)d_in[7]; a.w_uv = (const float*)d_in[8]; a.rel_bias = (const float*)d_in[9];
    a.w_out = (const float*)d_in[10]; a.norm_cross = (const float*)d_in[11]; a.norm_mem = (const float*)d_in[12]; a.w_cq = (const float*)d_in[13]; a.w_ck = (const float*)d_in[14];
    a.w_cv = (const float*)d_in[15]; a.w_co = (const float*)d_in[16]; a.norm_ffn = (const float*)d_in[17]; a.w_router = (const float*)d_in[18]; a.b_router = (const float*)d_in[19];
    a.w_gu = (const float*)d_in[20]; a.b_gu = (const float*)d_in[21]; a.w_down = (const float*)d_in[22]; a.b_down = (const float*)d_in[23]; a.norm_final = (const float*)d_in[24];
    a.out = (float*)d_out; a.ws = (unsigned char*)d_ws; a.pad = 0;
#if MK_ONE_LAUNCH
    a.ph_lo = 0; a.ph_hi = N_PHASES; a.use_bar = 1;
    hipLaunchKernelGGL(fwd_kernel, dim3(grid), dim3(NTHREADS), LDS_BYTES, stream, a);
#else
    for (int p = 0; p < N_PHASES; ++p) { a.ph_lo = p; a.ph_hi = p + 1; a.use_bar = 0; const int reps = ((REP_MASK >> p) & 1) ? 2 : 1;
        for (int r = 0; r < reps; ++r) hipLaunchKernelGGL(fwd_kernel, dim3(grid), dim3(NTHREADS), LDS_BYTES, stream, a); }
#endif
}
```

```cpp
#include <hip/hip_runtime.h>
#include <cstdio>
#include <cstdint>
#include <cmath>

#define LAS __attribute__((address_space(3)))
#define GAS __attribute__((address_space(1)))
typedef unsigned short bf16;
typedef short bf16x8 __attribute__((ext_vector_type(8)));
typedef short s16x4 __attribute__((ext_vector_type(4)));
typedef float f32x4 __attribute__((ext_vector_type(4)));
typedef float f32x2 __attribute__((ext_vector_type(2)));
typedef float f32x16 __attribute__((ext_vector_type(16)));
typedef unsigned u32x4 __attribute__((ext_vector_type(4)));
typedef int i32x4 __attribute__((ext_vector_type(4)));
typedef unsigned u32x2 __attribute__((ext_vector_type(2)));
typedef LAS unsigned char lds_t;

constexpr int BATCH = 4, SEQ = 8192, T = BATCH * SEQ, DM = 2048;
constexpr int NPROJ = 5632;
constexpr int C_QATT = 0, C_CKV = 1024, C_QIDX = 1280, C_KIDX = 2304, C_WIDX = 2368, C_QRET = 2560, C_KRET = 3072, C_VRET = 3584, C_GRET = 4608;
constexpr int IN_WIDTH = 5456;
constexpr int NE = 32, TOPK = 4, DFF = 2048;
constexpr int SLOTS = T * TOPK + NE * 256;
constexpr int NMEM = 256;
constexpr float EPS = 1e-6f;
constexpr float LOG2E = 1.4426950408889634f;

constexpr size_t MiB = 1u << 20;
constexpr size_t WS_CTL = 0, CTL_ZERO_BYTES = 1 * MiB;
constexpr size_t WS_WIN_T = 1 * MiB, WS_WOUT_T = 23 * MiB, WS_WCQ_T = 31 * MiB, WS_WCKV_T = 33 * MiB, WS_WCO_T = 37 * MiB, WS_WUK = 39 * MiB, WS_WUVP = 40 * MiB;
constexpr size_t WS_WGU_T = 41 * MiB, WS_WD_T = 553 * MiB;
constexpr size_t WS_HN = 809 * MiB, WS_MEMN = 937 * MiB, WS_KVC = 941 * MiB, WS_QC = 943 * MiB, WS_OC = 975 * MiB, WS_ROUTE = 1007 * MiB;
constexpr size_t WS_X = 1011 * MiB;
constexpr size_t X_PROJ = WS_X, X_QLAT = WS_X + 352 * MiB, X_SEL = WS_X + 480 * MiB, X_NSEL = WS_X + 512 * MiB, X_KV = WS_X + 513 * MiB, X_RPREV = WS_X + 641 * MiB, X_MIX = WS_X + 705 * MiB, X_ROPE = WS_X + 833 * MiB, X_OLAT = WS_X + 849 * MiB, X_KFRAG = WS_X + 977 * MiB, X_CKV8 = WS_X + 981 * MiB;
constexpr size_t X_ASORT = WS_X, X_HMID = WS_X + 272 * MiB, X_Y = WS_X + 544 * MiB;
constexpr size_t WS_HRES = WS_X + 1088 * MiB;
constexpr size_t WS_END = WS_HRES + 128 * MiB;
constexpr size_t R_TOKE = WS_ROUTE, R_TOKPOS = WS_ROUTE + MiB / 2, R_TOKGATE = WS_ROUTE + MiB, R_TOKSLOT = WS_ROUTE + 3 * MiB / 2, R_SLOTGATE = WS_ROUTE + 2 * MiB, R_SLOTTOK = WS_ROUTE + 3 * MiB;
constexpr size_t WS_SSQ1 = WS_HN, WS_SSQ2 = WS_HN + 2 * MiB, WS_SLOTRSTD = WS_HN + 4 * MiB;
constexpr int CW_TMO = 0, CW_BAR = 4096, CW_ECNT = 16384;

constexpr int IDX_NB = 2;
constexpr int LDS_BYTES = 163840;
constexpr int MISC_OFF = LDS_BYTES - 256;
constexpr int MOE_TAB_OFF = 131072;

constexpr int NWAVES = 8, NTHREADS = 512;

__device__ __forceinline__ unsigned f2bf(float f) { unsigned u = __float_as_uint(f); return (u + 0x7fffu + ((u >> 16) & 1u)) >> 16; }
__device__ __forceinline__ unsigned pk2(float lo, float hi) { typedef __bf16 bf16x2_t_ __attribute__((ext_vector_type(2))); return __builtin_bit_cast(unsigned, __builtin_convertvector((f32x2){lo, hi}, bf16x2_t_)); }
__device__ __forceinline__ float bflo(unsigned w) { return __uint_as_float(w << 16); }
__device__ __forceinline__ float bfhi(unsigned w) { return __uint_as_float(w & 0xffff0000u); }
__device__ __forceinline__ float bf2f(bf16 v) { return __uint_as_float((unsigned)v << 16); }
__device__ __forceinline__ unsigned pk4_fp8(float a, float b, float c, float d) {
    a = __builtin_amdgcn_fmed3f(a, -448.f, 448.f); b = __builtin_amdgcn_fmed3f(b, -448.f, 448.f); c = __builtin_amdgcn_fmed3f(c, -448.f, 448.f); d = __builtin_amdgcn_fmed3f(d, -448.f, 448.f);
    int r = __builtin_amdgcn_cvt_pk_fp8_f32(a, b, 0, false); r = __builtin_amdgcn_cvt_pk_fp8_f32(c, d, r, true); return (unsigned)r; }
__device__ __forceinline__ unsigned pk4_fp8_nc(float a, float b, float c, float d) {
    int r = __builtin_amdgcn_cvt_pk_fp8_f32(a, b, 0, false); r = __builtin_amdgcn_cvt_pk_fp8_f32(c, d, r, true); return (unsigned)r; }
constexpr float Y_S = 16.0f;
constexpr float IDX_QS = 16.0f, IDX_KS = 16.0f;
constexpr float CKV_S = 16.0f;
constexpr float FP8_RS = 8.0f;
constexpr float FP8_XS = 8.0f, FP8_WS = 32.0f, FP8_HS = 4.0f;
#define LDS_WAIT() asm volatile("s_waitcnt lgkmcnt(0)" ::: "memory")
#define VM_WAIT() asm volatile("s_waitcnt vmcnt(0)" ::: "memory")
__device__ __forceinline__ float wave_sum(float v) {
#pragma unroll
    for (int o = 1; o < 64; o <<= 1) v += __shfl_xor(v, o);
    return v;
}
__device__ __forceinline__ s16x4 tr_read(const lds_t* p) {
    typedef short v4i16_t __attribute__((ext_vector_type(4)));
    return __builtin_bit_cast(s16x4, __builtin_amdgcn_ds_read_tr16_b64_v4i16((LAS v4i16_t*)p));
}
__device__ __forceinline__ bf16x8 cat4(s16x4 a, s16x4 b) { bf16x8 r; r[0] = a[0]; r[1] = a[1]; r[2] = a[2]; r[3] = a[3]; r[4] = b[0]; r[5] = b[1]; r[6] = b[2]; r[7] = b[3]; return r; }
__device__ __forceinline__ unsigned off_b(unsigned row, unsigned ch) { return 256u * row + 16u * (ch ^ (((row & 3u) << 2) | ((row >> 2) & 3u))); }
__device__ __forceinline__ unsigned tr_addr16(unsigned lane, unsigned row0, unsigned c, unsigned t) {
    const unsigned g = lane >> 4, q = (lane & 15u) >> 2, p = lane & 3u;
    return off_b(row0 + 8u * g + 4u * t + q, 2u * c + (p >> 1)) + 8u * (p & 1u);
}

#define DECL_AROW(arow) unsigned arow[2][4]; _Pragma("unroll") for (int rb_ = 0; rb_ < 2; ++rb_) _Pragma("unroll") for (int s_ = 0; s_ < 4; ++s_) \
    arow[rb_][s_] = off_b(8u * ((lane & 15) >> 2) + 4u * rb_ + (lane & 3), 4u * s_ + (lane >> 4))
#define DECL_TRB(trb) unsigned trb[2][8]; _Pragma("unroll") for (int t_ = 0; t_ < 2; ++t_) _Pragma("unroll") for (int c_ = 0; c_ < 8; ++c_) trb[t_][c_] = tr_addr16(lane, 0, c_, t_)

namespace pg8 {
constexpr int BM = 256, BK = 64, HALF = 128, HTB = HALF * BK * 2, STAGE_BYTES = 8 * HTB;
__host__ __device__ __forceinline__ int lds_byte(int r, int c) { const int st = (r >> 4) * 2 + (c >> 5), rr = r & 15, cc = c & 31, ob = rr * 64 + cc * 2; return st * 1024 + (ob ^ (((ob >> 9) & 1) << 5)); }
__host__ __device__ __forceinline__ void stage_rc(int b, int& R, int& C) { const int st = b / 1024, sb = b % 1024, swz = sb ^ (((sb >> 9) & 1) << 5); R = (st >> 1) * 16 + swz / 64; C = (st & 1) * 32 + (swz % 64) / 2; }
__host__ __device__ __forceinline__ int perm32(int rho) { const int n = rho >> 4, i = rho & 15; return 8 * (i >> 2) + 4 * n + (i & 3); }

struct Unit { const char* A; const char* B; char* C; const char* R; int e; int pn; int m0; };

struct DenseSched {
    int nM, nN, nwg, G, c;
    const char* A0; const char* B0; char* C0; const char* R0;
    long a_pm, a_pn, b_pn, c_pm, c_pn, r_pm, r_pn; int a_sh;
    __device__ __forceinline__ bool next(int i, Unit& u) const {
        const long L = (long)i * G + c; if (L >= nwg) return false;
        int wgid = (int)L; { const int q = nwg / 8, r = nwg % 8, xcd = wgid % 8, off = wgid / 8; wgid = (xcd < r ? xcd * (q + 1) : r * (q + 1) + (xcd - r) * q) + off; }
        const int nig = 8 * nN, gid = wgid / nig, fm = gid * 8, gsz = (nM - fm) < 8 ? (nM - fm) : 8;
        const int pm = fm + ((wgid % nig) % gsz), pn = (wgid % nig) / gsz;
        u.A = A0 + pm * a_pm + (pn >> a_sh) * a_pn; u.B = B0 + pn * b_pn; u.C = C0 + pm * c_pm + pn * c_pn; u.R = R0 ? R0 + pm * r_pm + pn * r_pn : nullptr; u.e = pm; u.pn = pn; u.m0 = 0; return true;
    }
};
struct MoeSched {
    int NT, nunits, G, c;
    const LAS int* tab;
    const int* rowmap = nullptr; LAS int* idxb = nullptr;
    const char* A0; const char* B0; char* C0; const char* R0;
    long a_mt, b_e, b_pn, c_mt, c_pn, r_mt;
    __device__ __forceinline__ bool next(int i, Unit& u) const {
        const long L = (long)i * G + c; if (L >= nunits) return false;
        const int mt = (int)(L / NT), pn = (int)(L % NT);
        const int e = __builtin_amdgcn_readfirstlane(tab[mt]);
        u.A = A0 + mt * a_mt; u.B = B0 + e * b_e + pn * b_pn; u.C = C0 + mt * c_mt + pn * c_pn; u.R = R0 + mt * r_mt; u.e = e; u.pn = pn; u.m0 = mt * 256; return true;
    }
};

__device__ __forceinline__ unsigned cvt_pk_bf16(float lo, float hi) { unsigned r; asm volatile("v_cvt_pk_bf16_f32 %0, %1, %2" : "=v"(r) : "v"(lo), "v"(hi)); return r; }

struct EpiBf16S {
    static constexpr bool PERM = true;
    int ldc; float scale;
    __device__ __forceinline__ void operator()(const f32x4 (&acc)[2][2][4][2], const Unit& u, int wr, int wc, int fr, int fq) const {
        asm volatile("" : "+v"(fr), "+v"(fq));
        bf16* C = (bf16*)u.C; const int row0 = wr * 64 + fr, col0 = wc * 32 + 8 * fq;
#pragma unroll
        for (int ai = 0; ai < 2; ++ai)
#pragma unroll
            for (int m = 0; m < 4; ++m) { bf16* rowp = C + (size_t)(row0 + ai * HALF + m * 16) * ldc + col0;
#pragma unroll
                for (int bj = 0; bj < 2; ++bj) { const f32x4 v0 = acc[ai][bj][m][0] * scale, v1 = acc[ai][bj][m][1] * scale;
                    u32x4 w; w.x = cvt_pk_bf16(v0[0], v0[1]); w.y = cvt_pk_bf16(v0[2], v0[3]); w.z = cvt_pk_bf16(v1[0], v1[1]); w.w = cvt_pk_bf16(v1[2], v1[3]);
                    *(u32x4*)(rowp + bj * HALF) = w; } }
    }
};
struct EpiBf16RS {
    static constexpr bool PERM = true;
    int ldc; const float* ssq;
    __device__ __forceinline__ void operator()(const f32x4 (&acc)[2][2][4][2], const Unit& u, int wr, int wc, int fr, int fq) const {
        asm volatile("" : "+v"(fr), "+v"(fq));
        bf16* C = (bf16*)u.C; const int row0 = wr * 64 + fr, col0 = wc * 32 + 8 * fq;
        const float* sp = ssq + ((size_t)u.e * 256 + row0) * 8;
        f32x4 pa[8][2];
#pragma unroll
        for (int g = 0; g < 8; ++g) { const float* p = sp + (size_t)((g >> 2) * HALF + (g & 3) * 16) * 8; pa[g][0] = *(const f32x4*)p; pa[g][1] = *(const f32x4*)(p + 4); }
#pragma unroll
        for (int g = 0; g < 8; ++g) { const float s = ((pa[g][0][0] + pa[g][0][1]) + (pa[g][0][2] + pa[g][0][3])) + ((pa[g][1][0] + pa[g][1][1]) + (pa[g][1][2] + pa[g][1][3]));
            const float rstd = rsqrtf(s * (1.0f / DM) + EPS);
            bf16* rowp = C + (size_t)(row0 + (g >> 2) * HALF + (g & 3) * 16) * ldc + col0;
#pragma unroll
            for (int bj = 0; bj < 2; ++bj) { const f32x4 v0 = acc[g >> 2][bj][g & 3][0] * rstd, v1 = acc[g >> 2][bj][g & 3][1] * rstd;
                u32x4 w; w.x = cvt_pk_bf16(v0[0], v0[1]); w.y = cvt_pk_bf16(v0[2], v0[3]); w.z = cvt_pk_bf16(v1[0], v1[1]); w.w = cvt_pk_bf16(v1[2], v1[3]);
                *(u32x4*)(rowp + bj * HALF) = w; } }
    }
};
struct EpiResF32 {
    static constexpr bool PERM = false;
    int ldc;
    __device__ __forceinline__ void operator()(const f32x4 (&acc)[2][2][4][2], const Unit& u, int wr, int wc, int fr, int fq) const {
        asm volatile("" : "+v"(fr), "+v"(fq));
        float* C = (float*)u.C; const float* R = (const float*)u.R; const int row0 = wr * 64 + fr, col0 = wc * 32 + 4 * fq;
#pragma unroll
        for (int ai = 0; ai < 2; ++ai)
#pragma unroll
            for (int m = 0; m < 4; ++m) { const size_t ro = (size_t)(row0 + ai * HALF + m * 16) * ldc + col0;
#pragma unroll
                for (int bj = 0; bj < 2; ++bj)
#pragma unroll
                    for (int n = 0; n < 2; ++n) { const size_t o = ro + bj * HALF + n * 16; *(f32x4*)(C + o) = *(const f32x4*)(R + o) + acc[ai][bj][m][n]; } }
    }
};
struct EpiResBf16 {
    static constexpr bool PERM = true;
    int ldc, ldr; bool rf32;
    unsigned char* h8 = nullptr; const float* gain = nullptr;
    float* ssq = nullptr; LAS float* part = nullptr;
    __device__ __forceinline__ void operator()(const f32x4 (&acc)[2][2][4][2], const Unit& u, int wr, int wc, int fr, int fq) const {
        asm volatile("" : "+v"(fr), "+v"(fq));
        bf16* C = (bf16*)u.C; const int row0 = wr * 64 + fr, col0 = wc * 32 + 8 * fq;
        if (rf32) {
            const float* R = (const float*)u.R + (size_t)row0 * ldr + col0;
            f32x4 rb[8][2][2]; u32x4 w0[2], w1[2];
#define ERB_LOAD(g) do { _Pragma("unroll") for (int bj = 0; bj < 2; ++bj) { const float* rp = R + (size_t)(((g) >> 2) * HALF + ((g) & 3) * 16) * ldr + bj * HALF; rb[g][bj][0] = *(const f32x4*)rp; rb[g][bj][1] = *(const f32x4*)(rp + 4); } } while (0)
#define ERB_PACK(g, WV) do { float sq_ = 0.f; _Pragma("unroll") for (int bj = 0; bj < 2; ++bj) { const f32x4 v0 = acc[(g) >> 2][bj][(g) & 3][0] + rb[g][bj][0], v1 = acc[(g) >> 2][bj][(g) & 3][1] + rb[g][bj][1]; \
                sq_ += ((v0[0] * v0[0] + v0[1] * v0[1]) + (v0[2] * v0[2] + v0[3] * v0[3])) + ((v1[0] * v1[0] + v1[1] * v1[1]) + (v1[2] * v1[2] + v1[3] * v1[3])); \
                WV[bj].x = cvt_pk_bf16(v0[0], v0[1]); WV[bj].y = cvt_pk_bf16(v0[2], v0[3]); WV[bj].z = cvt_pk_bf16(v1[0], v1[1]); WV[bj].w = cvt_pk_bf16(v1[2], v1[3]); } \
                if (ssq) { sq_ += __shfl_xor(sq_, 16); sq_ += __shfl_xor(sq_, 32); if (fq == 0) part[(wr * 64 + fr + ((g) >> 2) * HALF + ((g) & 3) * 16) * 4 + wc] = sq_; } } while (0)
#define ERB_STORE(g, WV) do { bf16* rowp = C + (size_t)(row0 + ((g) >> 2) * HALF + ((g) & 3) * 16) * ldc + col0; *(u32x4*)rowp = WV[0]; *(u32x4*)(rowp + HALF) = WV[1]; } while (0)
            ERB_LOAD(0); ERB_LOAD(1); ERB_LOAD(2); ERB_LOAD(3); ERB_LOAD(4);
            __builtin_amdgcn_sched_barrier(0);
            ERB_PACK(0, w0); ERB_PACK(1, w1);
            __builtin_amdgcn_sched_barrier(0);
            ERB_LOAD(5); ERB_LOAD(6);
            __builtin_amdgcn_sched_barrier(0);
            ERB_STORE(0, w0); ERB_STORE(1, w1);
            ERB_PACK(2, w0);
            __builtin_amdgcn_sched_barrier(0);
            ERB_LOAD(7);
            __builtin_amdgcn_sched_barrier(0);
            ERB_STORE(2, w0);
#pragma unroll
            for (int g = 3; g < 8; ++g) { ERB_PACK(g, w0); ERB_STORE(g, w0); }
            if (ssq) {
                asm volatile("s_waitcnt lgkmcnt(0)" ::: "memory"); __builtin_amdgcn_s_barrier();
                const int t_ = threadIdx.x;
                if (t_ < 256) { const f32x4 p = *(const LAS f32x4*)(part + t_ * 4); ssq[((size_t)u.e * 256 + t_) * 8 + u.pn] = (p[0] + p[1]) + (p[2] + p[3]); }
            }
#undef ERB_LOAD
#undef ERB_PACK
#undef ERB_STORE
        } else {
            const bf16* R = (const bf16*)u.R + (size_t)row0 * ldr + col0;
            u32x4 rw[8][2], oA[2], oB[2]; u32x2 hA[2], hB[2];
#define ERC_LOAD(g) do { _Pragma("unroll") for (int bj = 0; bj < 2; ++bj) rw[g][bj] = *(const u32x4*)(R + (size_t)(((g) >> 2) * HALF + ((g) & 3) * 16) * ldr + bj * HALF); } while (0)
#define ERC_PACK(g, OV, HV) do { float sq_ = 0.f; _Pragma("unroll") for (int bj = 0; bj < 2; ++bj) { const u32x4 w = rw[g][bj]; \
                const f32x4 r0 = (f32x4){bflo(w.x), bfhi(w.x), bflo(w.y), bfhi(w.y)}, r1 = (f32x4){bflo(w.z), bfhi(w.z), bflo(w.w), bfhi(w.w)}; \
                const f32x4 v0 = acc[(g) >> 2][bj][(g) & 3][0] + r0, v1 = acc[(g) >> 2][bj][(g) & 3][1] + r1; \
                OV[bj].x = cvt_pk_bf16(v0[0], v0[1]); OV[bj].y = cvt_pk_bf16(v0[2], v0[3]); OV[bj].z = cvt_pk_bf16(v1[0], v1[1]); OV[bj].w = cvt_pk_bf16(v1[2], v1[3]); \
                if (h8) { sq_ += ((v0[0] * v0[0] + v0[1] * v0[1]) + (v0[2] * v0[2] + v0[3] * v0[3])) + ((v1[0] * v1[0] + v1[1] * v1[1]) + (v1[2] * v1[2] + v1[3] * v1[3])); \
                    const f32x4 q0 = v0 * gq[bj][0], q1 = v1 * gq[bj][1]; HV[bj] = (u32x2){pk4_fp8(q0[0], q0[1], q0[2], q0[3]), pk4_fp8(q1[0], q1[1], q1[2], q1[3])}; } } \
            if (h8) { sq_ += __shfl_xor(sq_, 16); sq_ += __shfl_xor(sq_, 32); if (fq == 0) part[(row0 + ((g) >> 2) * HALF + ((g) & 3) * 16) * 4 + wc] = sq_; } } while (0)
#define ERC_STORE(g, OV, HV) do { const int row = row0 + ((g) >> 2) * HALF + ((g) & 3) * 16; bf16* rowp = C + (size_t)row * ldc + col0; *(u32x4*)rowp = OV[0]; *(u32x4*)(rowp + HALF) = OV[1]; \
            if (h8) { unsigned char* hp = h8 + ((size_t)u.e * 256 + row) * DM + u.pn * 256 + col0; *(u32x2*)hp = HV[0]; *(u32x2*)(hp + HALF) = HV[1]; } } while (0)
            ERC_LOAD(0); ERC_LOAD(1); ERC_LOAD(2); ERC_LOAD(3); ERC_LOAD(4); ERC_LOAD(5);
            f32x4 gq[2][2];
            if (h8) {
#pragma unroll
                for (int bj = 0; bj < 2; ++bj) { const float* gp = gain + u.pn * 256 + col0 + bj * HALF; gq[bj][0] = *(const f32x4*)gp * FP8_RS; gq[bj][1] = *(const f32x4*)(gp + 4) * FP8_RS; }
            }
            __builtin_amdgcn_sched_barrier(0);
            ERC_PACK(0, oA, hA); ERC_PACK(1, oB, hB);
            __builtin_amdgcn_sched_barrier(0);
            ERC_LOAD(6); ERC_LOAD(7);
            __builtin_amdgcn_sched_barrier(0);
            ERC_STORE(0, oA, hA); ERC_STORE(1, oB, hB);
#pragma unroll
            for (int g = 2; g < 8; ++g) { ERC_PACK(g, oA, hA); ERC_STORE(g, oA, hA); }
#undef ERC_LOAD
#undef ERC_PACK
#undef ERC_STORE
            if (h8) {
                asm volatile("s_waitcnt lgkmcnt(0)" ::: "memory"); __builtin_amdgcn_s_barrier();
                const int t_ = threadIdx.x;
                if (t_ < 256) { const f32x4 p = *(const LAS f32x4*)(part + t_ * 4); ssq[((size_t)u.e * 256 + t_) * 8 + u.pn] = (p[0] + p[1]) + (p[2] + p[3]); }
            }
        }
    }
};
struct EpiSwiglu {
    static constexpr bool PERM = true;
    const float* b_gu;
    const float* row_rstd;
    __device__ __forceinline__ void operator()(const f32x4 (&acc)[2][2][4][2], const Unit& u, int wr, int wc, int fr, int fq) const {
        asm volatile("" : "+v"(fr), "+v"(fq));
        const int row0 = wr * 64 + fr, colw = wc * 32 + 8 * fq;
        const float* bp = b_gu + (size_t)u.e * (2 * DFF) + u.pn * 128 + colw;
        constexpr float CS = 1.0f / (FP8_RS * FP8_WS), KE = -1.702f * LOG2E, CK = CS * KE, XMIN = 7.0f * KE, UPS = FP8_HS / KE;
        f32x4 bgk[2], bu[2]; float rs[8];
#pragma unroll
        for (int n = 0; n < 2; ++n) { bgk[n] = *(const f32x4*)(bp + 4 * n) * KE; bu[n] = *(const f32x4*)(bp + DFF + 4 * n); }
#pragma unroll
        for (int g = 0; g < 8; ++g) rs[g] = row_rstd[u.m0 + row0 + (g >> 2) * HALF + (g & 3) * 16];
#pragma unroll
        for (int ai = 0; ai < 2; ++ai)
#pragma unroll
            for (int m = 0; m < 4; ++m) { unsigned char* rowp = (unsigned char*)u.C + (size_t)(row0 + ai * HALF + m * 16) * DFF + colw;
                f32x4 h[2];
                const float ck = rs[ai * 4 + m] * CK, cs = rs[ai * 4 + m] * CS;
#pragma unroll
                for (int n = 0; n < 2; ++n) { f32x4 x = acc[ai][0][m][n] * ck + bgk[n], uu = acc[ai][1][m][n] * cs + bu[n], r;
#pragma unroll
                    for (int j = 0; j < 4; ++j) { x[j] = fmaxf(x[j], XMIN); uu[j] = fminf(fmaxf(uu[j], -7.0f), 7.0f); }
#pragma unroll
                    for (int j = 0; j < 4; ++j) r[j] = __builtin_amdgcn_exp2f(x[j]);
                    r = r + 1.0f;
#pragma unroll
                    for (int j = 0; j < 4; ++j) r[j] = __builtin_amdgcn_rcpf(r[j]);
                    h[n] = (uu * UPS + UPS) * (x * r); }
                *(u32x2*)rowp = (u32x2){pk4_fp8_nc(h[0][0], h[0][1], h[0][2], h[0][3]), pk4_fp8_nc(h[1][0], h[1][1], h[1][2], h[1][3])}; }
    }
};
struct EpiDown {
    static constexpr bool PERM = true;
    const float* b_down;
    __device__ __forceinline__ void operator()(const f32x4 (&acc)[2][2][4][2], const Unit& u, int wr, int wc, int fr, int fq) const {
        asm volatile("" : "+v"(fr), "+v"(fq));
        const float* gate = (const float*)u.R; const int row0 = wr * 64 + fr, colw = wc * 32 + 8 * fq;
        const float* bp = b_down + (size_t)u.e * DM + u.pn * 256 + colw;
        f32x4 bd[2][2];
#pragma unroll
        for (int bj = 0; bj < 2; ++bj)
#pragma unroll
            for (int n = 0; n < 2; ++n) bd[bj][n] = *(const f32x4*)(bp + bj * HALF + 4 * n);
        float gts[8];
#pragma unroll
        for (int g = 0; g < 8; ++g) gts[g] = gate[row0 + (g >> 2) * HALF + (g & 3) * 16];
        __builtin_amdgcn_sched_barrier(0);
#pragma unroll
        for (int ai = 0; ai < 2; ++ai)
#pragma unroll
            for (int m = 0; m < 4; ++m) { const int row = row0 + ai * HALF + m * 16; const float gt = gts[ai * 4 + m] * Y_S; unsigned char* rowp = (unsigned char*)u.C + (size_t)row * DM + colw;
#pragma unroll
                for (int bj = 0; bj < 2; ++bj) { const f32x4 v0 = (acc[ai][bj][m][0] * (1.0f / (FP8_HS * FP8_WS)) + bd[bj][0]) * gt, v1 = (acc[ai][bj][m][1] * (1.0f / (FP8_HS * FP8_WS)) + bd[bj][1]) * gt;
                    *(u32x2*)(rowp + bj * HALF) = (u32x2){pk4_fp8(v0[0], v0[1], v0[2], v0[3]), pk4_fp8(v1[0], v1[1], v1[2], v1[3])}; } }
    }
};

template <class Epi, class Sched, bool ALIGN_EPI, bool FP8 = false, bool GATHER = false>
__device__ __forceinline__ void gemm_phase(lds_t* lds, const int K, const int lda, const int ldb, const Sched& S, const Epi& E) {
    const int tid = threadIdx.x, wid = __builtin_amdgcn_readfirstlane(tid >> 6), lane = tid & 63, wr = wid >> 2, wc = wid & 3, fr = lane & 15, fq = lane >> 4;
    const int nt = K / BK;
    unsigned voffA[2], voffB[2];
#pragma unroll
    for (int i = 0; i < 2; ++i) { int R, C; stage_rc(tid * 16 + i * 8192, R, C); const int Rb = Epi::PERM ? ((R & ~31) + perm32(R & 31)) : R;
        voffA[i] = (unsigned)(R * lda + C) * 2u; voffB[i] = (unsigned)(Rb * ldb + C) * 2u; }
    const size_t kstep = (size_t)(BK * 2);
    const size_t hstepA = GATHER ? (size_t)0 : (size_t)HALF * lda * 2, hstepB = (size_t)HALF * ldb * 2;
    const unsigned ldsw = (unsigned)wid * 1024u;
    const int aoff = lds_byte(wr * 64 + fr, fq * 8), boff = lds_byte(wc * 32 + fr, fq * 8);
    unsigned voffA1[2] = {0u, 0u};
#define PG8_GOFF(dst0, dst1, ibase) do { _Pragma("unroll") for (int _i = 0; _i < 2; ++_i) { int R_, C_; stage_rc(tid * 16 + _i * 8192, R_, C_); \
        dst0[_i] = (unsigned)(ibase)[R_] * (unsigned)(lda * 2) + (unsigned)C_ * 2u; dst1[_i] = (unsigned)(ibase)[R_ + HALF] * (unsigned)(lda * 2) + (unsigned)C_ * 2u; } } while (0)
#define PG8_SA(b, h) (((b) * 2 + (h)) * HTB)
#define PG8_SB(b, h) ((4 + (b) * 2 + (h)) * HTB)
#define PG8_STAGE(bufoff, gbase, voff) do { _Pragma("unroll") for (int _i = 0; _i < 2; ++_i) \
        __builtin_amdgcn_global_load_lds((const unsigned*)((const char*)(gbase) + (voff)[_i]), (LAS unsigned*)(lds + (bufoff) + ldsw + _i * 8192), 16, 0, 0); } while (0)
#define PG8_LD8(off_) __builtin_shufflevector(*(const LAS v4i_t*)(lds + (off_)), *(const LAS v4i_t*)(lds + (off_) + 1024), 0, 1, 2, 3, 4, 5, 6, 7)
#define PG8_LDA(dst, b, h) do { if constexpr (FP8) { _Pragma("unroll") for (int m = 0; m < 4; ++m) dst##8[m] = PG8_LD8(PG8_SA(b, h) + aoff + m * 2048); } \
        else { _Pragma("unroll") for (int m = 0; m < 4; ++m) _Pragma("unroll") for (int k = 0; k < 2; ++k) dst[m][k] = *(const LAS bf16x8*)(lds + PG8_SA(b, h) + aoff + m * 2048 + k * 1024); } } while (0)
#define PG8_LDB(dst, b, h) do { if constexpr (FP8) { _Pragma("unroll") for (int n = 0; n < 2; ++n) dst##8[n] = PG8_LD8(PG8_SB(b, h) + boff + n * 2048); } \
        else { _Pragma("unroll") for (int n = 0; n < 2; ++n) _Pragma("unroll") for (int k = 0; k < 2; ++k) dst[n][k] = *(const LAS bf16x8*)(lds + PG8_SB(b, h) + boff + n * 2048 + k * 1024); } } while (0)
#define PG8_MMA(ai, bj, At, Bt) do { __builtin_amdgcn_s_setprio(1); _Pragma("unroll") for (int m = 0; m < 4; ++m) _Pragma("unroll") for (int n = 0; n < 2; ++n) { \
        if constexpr (FP8) asm volatile("v_mfma_scale_f32_16x16x128_f8f6f4 %0, %1, %2, %0, %3, %3 op_sel_hi:[0,0,0]" : "+v"(acc[ai][bj][m][n]) : "v"(Bt##8[n]), "v"(At##8[m]), "v"(one_scale));   \
        else { _Pragma("unroll") for (int k = 0; k < 2; ++k) acc[ai][bj][m][n] = __builtin_amdgcn_mfma_f32_16x16x32_bf16(Bt[n][k], At[m][k], acc[ai][bj][m][n], 0, 0, 0); } } \
        __builtin_amdgcn_s_setprio(0); } while (0)
#define PG8_WAIT_V(n) asm volatile("s_waitcnt vmcnt(" #n ")" ::: "memory")
#define PG8_WAIT_L(n) asm volatile("s_waitcnt lgkmcnt(" #n ")" ::: "memory")
#define PG8_BAR __builtin_amdgcn_s_barrier()
#define PG8_SCHED __builtin_amdgcn_sched_barrier(0)
    Unit cur, nxt; int ui = 0;
    if (!S.next(0, cur)) return;
    f32x4 acc[2][2][4][2];
#pragma unroll
    for (int a = 0; a < 2; ++a)
#pragma unroll
        for (int b = 0; b < 2; ++b)
#pragma unroll
            for (int m = 0; m < 4; ++m)
#pragma unroll
                for (int n = 0; n < 2; ++n) acc[a][b][m][n] = (f32x4){0.f, 0.f, 0.f, 0.f};
    typedef int v8i_t __attribute__((ext_vector_type(8))); typedef int v4i_t __attribute__((ext_vector_type(4)));
    v8i_t At8[4], B08[2], B18[2]; bf16x8 At[4][2], B0[2][2], B1[2][2];
    const int one_scale = 0x7F7F7F7F;
    const char* cA = cur.A; const char* cB = cur.B;
    if constexpr (GATHER) { const int* rm_ = S.rowmap + cur.m0; PG8_GOFF(voffA, voffA1, rm_); }
#define voffAh1 (GATHER ? voffA1 : voffA)
    PG8_STAGE(PG8_SB(0, 0), cB, voffB); PG8_STAGE(PG8_SB(0, 1), cB + hstepB, voffB); PG8_STAGE(PG8_SA(0, 0), cA, voffA); PG8_STAGE(PG8_SA(0, 1), cA + hstepA, voffAh1);
    if (wr == 1) PG8_BAR;
    PG8_WAIT_V(2); PG8_BAR;
    PG8_STAGE(PG8_SB(1, 0), cB + kstep, voffB); PG8_STAGE(PG8_SA(1, 0), cA + kstep, voffA); PG8_STAGE(PG8_SB(1, 1), cB + hstepB + kstep, voffB);
    PG8_WAIT_V(6); PG8_BAR;
    for (;;) {
        const bool has_next = S.next(ui + 1, nxt);
        const char* nA = has_next ? nxt.A : cA; const char* nB = has_next ? nxt.B : cB;
        if constexpr (GATHER) {
            if (has_next) __builtin_amdgcn_global_load_lds((const unsigned*)(S.rowmap + nxt.m0 + (wid & 3) * 64 + lane), (LAS unsigned*)(S.idxb + ((ui + 1) & 1) * 256 + (wid & 3) * 64), 4, 0, 0);
        }
#pragma unroll 1
        for (int t = 0; t < nt; t += 2) {
            const bool last = (t == nt - 2);
            const char* a1 = cA + (size_t)(t + 1) * kstep;
            const char* a2 = last ? nA : cA + (size_t)(t + 2) * kstep; const char* b2 = last ? nB : cB + (size_t)(t + 2) * kstep;
            const char* a3 = a2 + kstep; const char* b3 = b2 + kstep;
            PG8_LDB(B0, 0, 0); PG8_LDB(B1, 0, 1); PG8_SCHED; PG8_LDA(At, 0, 0); PG8_STAGE(PG8_SA(1, 1), a1 + hstepA, voffAh1);
            if constexpr (GATHER) { if (last && has_next) { const LAS int* ib_ = S.idxb + ((ui + 1) & 1) * 256; PG8_GOFF(voffA, voffA1, ib_); } }
            PG8_WAIT_V(8); PG8_WAIT_L(0); PG8_BAR; PG8_MMA(0, 0, At, B0); PG8_MMA(0, 1, At, B1); PG8_BAR; PG8_SCHED;
            PG8_LDA(At, 0, 1); PG8_STAGE(PG8_SB(0, 0), b2, voffB); PG8_STAGE(PG8_SB(0, 1), b2 + hstepB, voffB); PG8_STAGE(PG8_SA(0, 0), a2, voffA);
            PG8_WAIT_V(8); PG8_WAIT_L(0); PG8_BAR; PG8_MMA(1, 0, At, B0); PG8_MMA(1, 1, At, B1); PG8_BAR; PG8_SCHED;
            PG8_LDB(B0, 1, 0); PG8_LDB(B1, 1, 1); PG8_SCHED; PG8_LDA(At, 1, 0); PG8_STAGE(PG8_SA(0, 1), a2 + hstepA, voffAh1);
            PG8_WAIT_V(8); PG8_WAIT_L(0); PG8_BAR; PG8_MMA(0, 0, At, B0); PG8_MMA(0, 1, At, B1); PG8_BAR; PG8_SCHED;
            PG8_LDA(At, 1, 1); PG8_STAGE(PG8_SB(1, 0), b3, voffB); PG8_STAGE(PG8_SB(1, 1), b3 + hstepB, voffB); PG8_STAGE(PG8_SA(1, 0), a3, voffA);
            PG8_WAIT_V(8); PG8_WAIT_L(0); PG8_BAR; PG8_MMA(1, 0, At, B0); PG8_MMA(1, 1, At, B1); PG8_BAR; PG8_SCHED;
        }
        if constexpr (ALIGN_EPI) { if (wr == 0) PG8_BAR; }
        if constexpr (FP8) { asm volatile("s_nop 15\n\ts_nop 15" ::: "memory"); __builtin_amdgcn_sched_barrier(0); }
        E(acc, cur, wr, wc, fr, fq);
        if (!has_next) break;
#pragma unroll
        for (int a = 0; a < 2; ++a)
#pragma unroll
            for (int b = 0; b < 2; ++b)
#pragma unroll
                for (int m = 0; m < 4; ++m)
#pragma unroll
                    for (int n = 0; n < 2; ++n) acc[a][b][m][n] = (f32x4){0.f, 0.f, 0.f, 0.f};
        cur = nxt; cA = nA; cB = nB; ++ui;
        if constexpr (ALIGN_EPI) { if (wr == 1) PG8_BAR; }
    }
    PG8_WAIT_V(0);
    if constexpr (!ALIGN_EPI) { if (wr == 0) PG8_BAR; }
    PG8_BAR;
#undef PG8_SA
#undef PG8_SB
#undef PG8_STAGE
#undef PG8_LDA
#undef PG8_LD8
#undef PG8_LDB
#undef PG8_MMA
#undef PG8_WAIT_V
#undef PG8_WAIT_L
#undef PG8_BAR
#undef PG8_SCHED
#undef PG8_GOFF
#undef voffAh1
}
}

#define XB_TMO      128
#define XB_XCNT(j)  (256  + 64 * (j))
#define XB_XSUB(j)  (1280 + 64 * (j))
#define XB_XGEN(j)  (2304 + 64 * (j))
#define XB_TOP      3328
#define XB_TOPGEN   3392
#define XCD_BAR_WORDS 3456
#define XB_SPIN_CAP (1u << 22)
__device__ __forceinline__ unsigned xb_ld(unsigned* p)              { return __hip_atomic_load(p, __ATOMIC_RELAXED, __HIP_MEMORY_SCOPE_AGENT); }
__device__ __forceinline__ unsigned xb_add(unsigned* p, unsigned v) { return __hip_atomic_fetch_add(p, v, __ATOMIC_RELAXED, __HIP_MEMORY_SCOPE_AGENT); }
__device__ __forceinline__ unsigned xb_xcc_id() { return (unsigned)__builtin_amdgcn_s_getreg((3 << 11) | 20) & 0xFu; }
#define XB_SPIN(cond, bar) do { unsigned _sp = 0; while (cond) { __builtin_amdgcn_s_sleep(1); \
    if ((++_sp & 255u) == 0u) { if (xb_ld(&(bar)[XB_TMO])) break; if (_sp > XB_SPIN_CAP) { atomicAdd(&(bar)[XB_TMO], 1u); break; } } } } while (0)
struct XcdBarrier { unsigned* bar; unsigned x; volatile LAS unsigned* st; };
__device__ __forceinline__ XcdBarrier xcd_barrier_post(unsigned* bar, volatile LAS unsigned* st) {
    XcdBarrier b; b.bar = bar; b.x = xb_xcc_id(); b.st = st;
    if (threadIdx.x == 0) (void)xb_add(&bar[XB_XCNT(b.x)], 1u);
    return b;
}
__device__ __forceinline__ void xcd_barrier_complete(unsigned* bar, unsigned x, unsigned& nloc, unsigned& nx) {
    const unsigned G = gridDim.x * gridDim.y * gridDim.z;
    unsigned sum, cnt, mine, sp = 0u;
    for (;;) {
        sum = 0u; cnt = 0u; mine = 0u;
#pragma unroll
        for (unsigned j = 0; j < 16; ++j) { const unsigned c = xb_ld(&bar[XB_XCNT(j)]); sum += c; cnt += (c > 0u) ? 1u : 0u; mine = (j == x) ? c : mine; }
        if (sum == G) break;
        __builtin_amdgcn_s_sleep(1);
        if ((++sp & 255u) == 0u) { if (xb_ld(&bar[XB_TMO])) break; if (sp > XB_SPIN_CAP) { atomicAdd(&bar[XB_TMO], 1u); break; } }
    }
    nloc = mine > 0u ? mine : 1u; nx = cnt > 0u ? cnt : 1u;
}
__device__ __forceinline__ void xcd_barrier(const XcdBarrier& b) {
    asm volatile("s_waitcnt vmcnt(0)" ::: "memory");
    __syncthreads();
    if (threadIdx.x == 0) {
        unsigned* bar = b.bar;
        __builtin_amdgcn_s_waitcnt(0);
        unsigned nloc = b.st[0], nx = b.st[1];
        if (nloc == 0u) { xcd_barrier_complete(bar, b.x, nloc, nx); b.st[0] = nloc; b.st[1] = nx; }
        const unsigned old = xb_add(&bar[XB_XSUB(b.x)], 1u);
        const unsigned gen = old / nloc;
        if (old + 1u == (gen + 1u) * nloc) {
            __builtin_amdgcn_fence(__ATOMIC_RELEASE, "agent");
            asm volatile("s_waitcnt vmcnt(0)" ::: "memory");
            const unsigned og = xb_add(&bar[XB_TOP], 1u);
            const unsigned tg = og / nx;
            if (og + 1u == (tg + 1u) * nx) xb_add(&bar[XB_TOPGEN], 1u);
            else XB_SPIN(xb_ld(&bar[XB_TOPGEN]) == tg, bar);
            __builtin_amdgcn_fence(__ATOMIC_ACQUIRE, "agent");
            xb_add(&bar[XB_XGEN(b.x)], 1u);
            asm volatile("s_waitcnt vmcnt(0)" ::: "memory");
        } else {
            XB_SPIN(xb_ld(&bar[XB_XGEN(b.x)]) == gen, bar);
            __builtin_amdgcn_fence(__ATOMIC_ACQUIRE, "agent");
            asm volatile("s_waitcnt vmcnt(0)" ::: "memory");
        }
    }
    __syncthreads();
}

struct Args {
    const float* x; const float* mem; const int* positions; const float* norm_mix; const float* w_in; const float* kv_norm; const float* idx_k_norm;
    const float* w_uk; const float* w_uv; const float* rel_bias; const float* w_out; const float* norm_cross; const float* norm_mem;
    const float* w_cq; const float* w_ck; const float* w_cv; const float* w_co; const float* norm_ffn; const float* w_router; const float* b_router;
    const float* w_gu; const float* b_gu; const float* w_down; const float* b_down; const float* norm_final;
    float* out; unsigned char* ws; int ph_lo, ph_hi; int use_bar, pad;
};

template <class Map>
__device__ __forceinline__ void transpose_item(const float* W, int ldw, bf16* WT, int ldt, int k0, int n0, LAS float* scr, int lane, Map map, const float* rs = nullptr) {
    const int c = lane & 31; const int src = map(n0 + c);
#pragma unroll 8
    for (int i = 0; i < 32; ++i) { const int kk = 2 * i + (lane >> 5); scr[kk * 33 + c] = (src >= 0) ? W[(size_t)(k0 + kk) * ldw + src] * (rs ? rs[k0 + kk] : 1.0f) : 0.f; }
    LDS_WAIT();
    const int ch = lane & 7;
#pragma unroll
    for (int j = 0; j < 4; ++j) { const int n = (lane >> 3) + 8 * j; const LAS float* s = scr + (8 * ch) * 33 + n;
        u32x4 o; o.x = pk2(s[0 * 33], s[1 * 33]); o.y = pk2(s[2 * 33], s[3 * 33]); o.z = pk2(s[4 * 33], s[5 * 33]); o.w = pk2(s[6 * 33], s[7 * 33]);
        *(u32x4*)(WT + (size_t)(n0 + n) * ldt + k0 + 8 * ch) = o; }
    LDS_WAIT();
}
template <class Map>
__device__ __forceinline__ void t8_load(f32x4 (&v)[16], const float* W, int ldw, int k0, int n0, int lane, Map map) {
    const int c4 = (lane & 7) * 4; const int src = map(n0 + c4);
#pragma unroll
    for (int i = 0; i < 16; ++i) v[i] = *(const f32x4*)(W + (size_t)(k0 + 8 * i + (lane >> 3)) * ldw + src);
}
__device__ __forceinline__ void t8_finish(const f32x4 (&v)[16], unsigned char* WT, int ldt, int k0, int n0, LAS float* scr, int lane, float sc) {
    const int c4 = (lane & 7) * 4;
#pragma unroll
    for (int i = 0; i < 16; ++i) { LAS float* d = scr + (8 * i + (lane >> 3)) * 33 + c4; d[0] = v[i].x * sc; d[1] = v[i].y * sc; d[2] = v[i].z * sc; d[3] = v[i].w * sc; }
    LDS_WAIT();
    const int ch = lane & 7;
#pragma unroll
    for (int j = 0; j < 4; ++j) { const int n = (lane >> 3) + 8 * j; const LAS float* s = scr + (16 * ch) * 33 + n;
        u32x4 o; o.x = pk4_fp8(s[0 * 33], s[1 * 33], s[2 * 33], s[3 * 33]); o.y = pk4_fp8(s[4 * 33], s[5 * 33], s[6 * 33], s[7 * 33]);
        o.z = pk4_fp8(s[8 * 33], s[9 * 33], s[10 * 33], s[11 * 33]); o.w = pk4_fp8(s[12 * 33], s[13 * 33], s[14 * 33], s[15 * 33]);
        *(u32x4*)(WT + (size_t)(n0 + n) * ldt + k0 + 16 * ch) = o; }
    LDS_WAIT();
}
__device__ __forceinline__ void rms_row_fp8(const float* xrow, const float* gain, unsigned char* orow, int lane, float sc) {
    const f32x4* xr = (const f32x4*)xrow + lane; const f32x4* gr = (const f32x4*)gain + lane;
    f32x4 v[8]; float s = 0.f;
#pragma unroll
    for (int j = 0; j < 8; ++j) { v[j] = xr[64 * j]; s += (v[j].x * v[j].x + v[j].y * v[j].y) + (v[j].z * v[j].z + v[j].w * v[j].w); }
    const float rstd = rsqrtf(wave_sum(s) * (1.f / DM) + EPS) * sc;
    unsigned* o4 = (unsigned*)orow + lane;
#pragma unroll
    for (int j = 0; j < 8; ++j) { const f32x4 g = gr[64 * j]; o4[64 * j] = pk4_fp8(v[j].x * rstd * g.x, v[j].y * rstd * g.y, v[j].z * rstd * g.z, v[j].w * rstd * g.w); }
}
__device__ __forceinline__ void rms_hrow_bf16(const bf16* hrow, const float* gain, bf16* orow, int lane) {
    const u32x2* xr = (const u32x2*)hrow + lane; const f32x4* gr = (const f32x4*)gain + lane;
    f32x4 v[8]; float s = 0.f;
#pragma unroll
    for (int j = 0; j < 8; ++j) { const u32x2 w = xr[64 * j]; v[j] = (f32x4){bflo(w.x), bfhi(w.x), bflo(w.y), bfhi(w.y)}; s += (v[j].x * v[j].x + v[j].y * v[j].y) + (v[j].z * v[j].z + v[j].w * v[j].w); }
    const float rstd = rsqrtf(wave_sum(s) * (1.f / DM) + EPS);
    u32x2* o8 = (u32x2*)orow + lane;
#pragma unroll
    for (int j = 0; j < 8; ++j) { const f32x4 g = gr[64 * j]; o8[64 * j] = (u32x2){pk2(v[j].x * rstd * g.x, v[j].y * rstd * g.y), pk2(v[j].z * rstd * g.z, v[j].w * rstd * g.w)}; }
}
__device__ __forceinline__ void rms_hrow_fp8(const bf16* hrow, const float* gain, unsigned char* orow, int lane, float sc) {
    const u32x2* xr = (const u32x2*)hrow + lane; const f32x4* gr = (const f32x4*)gain + lane;
    f32x4 v[8]; float s = 0.f;
#pragma unroll
    for (int j = 0; j < 8; ++j) { const u32x2 w = xr[64 * j]; v[j] = (f32x4){bflo(w.x), bfhi(w.x), bflo(w.y), bfhi(w.y)}; s += (v[j].x * v[j].x + v[j].y * v[j].y) + (v[j].z * v[j].z + v[j].w * v[j].w); }
    const float rstd = rsqrtf(wave_sum(s) * (1.f / DM) + EPS) * sc;
    unsigned* o4 = (unsigned*)orow + lane;
#pragma unroll
    for (int j = 0; j < 8; ++j) { const f32x4 g = gr[64 * j]; o4[64 * j] = pk4_fp8(v[j].x * rstd * g.x, v[j].y * rstd * g.y, v[j].z * rstd * g.z, v[j].w * rstd * g.w); }
}
__device__ __forceinline__ void rms_row_bf16(const float* xrow, const float* gain, bf16* orow, int lane) {
    const f32x4* xr = (const f32x4*)xrow + lane; const f32x4* gr = (const f32x4*)gain + lane;
    f32x4 v[8]; float s = 0.f;
#pragma unroll
    for (int j = 0; j < 8; ++j) { v[j] = xr[64 * j]; s += (v[j].x * v[j].x + v[j].y * v[j].y) + (v[j].z * v[j].z + v[j].w * v[j].w); }
    const float rstd = rsqrtf(wave_sum(s) * (1.f / DM) + EPS);
    unsigned long long* o8 = (unsigned long long*)orow + lane;
#pragma unroll
    for (int j = 0; j < 8; ++j) { const f32x4 g = gr[64 * j];
        o8[64 * j] = (unsigned long long)pk2(v[j].x * rstd * g.x, v[j].y * rstd * g.y) | ((unsigned long long)pk2(v[j].z * rstd * g.z, v[j].w * rstd * g.w) << 32); }
}
__device__ __forceinline__ int t5_bucket(int dist) {
    const int n = dist > 0 ? dist : 0;
    if (n < 16) return n;
    const float nf = (float)n;
    int large = 16 + (int)(logf(nf / 16.0f) / 2.0794415416798357f * 16.0f);
    return large < 31 ? large : 31;
}

struct CvtJob { const float* gu_src; const float* dn_src; unsigned char* gu_dst; unsigned char* dn_dst; };
__device__ __forceinline__ CvtJob cvt_job(const float* w_gu, const float* w_down, unsigned char* w_gu8, unsigned char* w_d8, int gwave, int lane) {
    const int e = gwave >> 6, nb = gwave & 63; CvtJob J;
    const int n = 64 * nb + lane;
    const int src = ((n & 255) < 128) ? 128 * (n >> 8) + (n & 127) : DFF + 128 * (n >> 8) + (n & 127);
    J.gu_src = w_gu + (size_t)e * DM * 2 * DFF + src; J.gu_dst = w_gu8 + (size_t)e * 2 * DFF * DM + (size_t)n * DM;
    const int n2 = 64 * (nb >> 1) + lane;
    J.dn_src = w_down + (size_t)e * DFF * DM + (size_t)(1024 * (nb & 1)) * DM + n2; J.dn_dst = w_d8 + (size_t)e * DM * DFF + (size_t)n2 * DFF + 1024 * (nb & 1);
    return J;
}
constexpr int CVT_ITEMS = 192;
#define CVT_ISSUE(R, j_) do { const int jc_ = (j_) < CVT_ITEMS ? (j_) : CVT_ITEMS - 1; const bool gu_ = jc_ < 128; const float* sp_ = gu_ ? J.gu_src + (size_t)(16 * jc_) * (2 * DFF) : J.dn_src + (size_t)(16 * (jc_ - 128)) * DM; \
        const size_t st_ = gu_ ? (size_t)(2 * DFF) : (size_t)DM; _Pragma("unroll") for (int i_ = 0; i_ < 16; ++i_) R[i_] = __builtin_nontemporal_load(sp_ + i_ * st_); } while (0)
#define CVT_DONE(R, j_) do { if ((j_) < CVT_ITEMS) { unsigned char* dp_ = ((j_) < 128) ? J.gu_dst + 16 * (j_) : J.dn_dst + 16 * ((j_) - 128); \
        *(u32x4*)dp_ = (u32x4){pk4_fp8(R[0] * FP8_WS, R[1] * FP8_WS, R[2] * FP8_WS, R[3] * FP8_WS), pk4_fp8(R[4] * FP8_WS, R[5] * FP8_WS, R[6] * FP8_WS, R[7] * FP8_WS), \
                               pk4_fp8(R[8] * FP8_WS, R[9] * FP8_WS, R[10] * FP8_WS, R[11] * FP8_WS), pk4_fp8(R[12] * FP8_WS, R[13] * FP8_WS, R[14] * FP8_WS, R[15] * FP8_WS)}; } } while (0)

__device__ __forceinline__ void idx_phase(const bf16* proj, const unsigned char* kfrag, int* sel, int* nsel, lds_t* lds, const int tid, const int lane, const int wave, const int bx, const int G,
                                          const bool do_cvt, const float* w_gu, const float* w_down, unsigned char* w_gu8, unsigned char* w_d8) {
    typedef __bf16 bf16x2_t __attribute__((ext_vector_type(2))); typedef short s16x2_t __attribute__((ext_vector_type(2)));
    LAS float* Sc = (LAS float*)lds;
    LAS unsigned* hist1 = (LAS unsigned*)(lds + 131072);
    LAS int* mm = (LAS int*)(lds + 155648);
    LAS unsigned* cnts = (LAS unsigned*)(lds + 155648 + 256);
    LAS int* cand = (LAS int*)(lds + 147456);
    for (int i = tid; i < 4096; i += NTHREADS) hist1[i] = 0u;
    if (tid < 4) { cnts[tid] = 0u; mm[2 * tid] = 0x7fffffff; mm[2 * tid + 1] = (int)0x80000000; }
    __syncthreads();
    const int r32 = lane & 31, hi = lane >> 5;
#define F2ORD(f) ({ const int b__ = __float_as_int(f); b__ ^ ((b__ >> 31) & 0x7fffffff); })
    typedef int v8i_t __attribute__((ext_vector_type(8)));
    bf16x8 Af[2][4], Wp[2][2]; v8i_t Af8[2];
#define IDX_FRAGS(gq_) do { const int b_ = (gq_) >> 11, t0_ = ((gq_) & 2047) * 4, rb_ = b_ * SEQ; \
        _Pragma("unroll") for (int rg_ = 0; rg_ < 2; ++rg_) { const int qrow_ = rb_ + t0_ + 2 * rg_ + ((r32 >> 2) & 1), head_ = (r32 & 3) + 4 * (r32 >> 3); \
            const bf16* ap_ = proj + (size_t)qrow_ * NPROJ + C_QIDX + head_ * 64 + 32 * hi; \
            _Pragma("unroll") for (int ks_ = 0; ks_ < 4; ++ks_) Af[rg_][ks_] = *(const bf16x8*)(ap_ + 8 * ks_); \
            const bf16* wp_ = proj + (size_t)(rb_ + t0_ + 2 * rg_ + hi) * NPROJ + C_WIDX; Wp[rg_][0] = *(const bf16x8*)wp_; Wp[rg_][1] = *(const bf16x8*)(wp_ + 8); } \
        } while (0)
    bool havepf = false;
    const CvtJob J = cvt_job(w_gu, w_down, w_gu8, w_d8, bx * NWAVES + wave, lane);
    int cj = do_cvt ? 0 : CVT_ITEMS;
    for (int gq = bx; gq < T / 4; gq += G) {
        const int b = gq >> 11, t0 = (gq & 2047) * 4; const int rowbase = b * SEQ;
        if (t0 < 256) {
            for (int i = tid; i < 1024; i += NTHREADS) { const int q = i >> 8, j = i & 255, t = t0 + q; sel[(size_t)(rowbase + t) * 256 + j] = (j <= t) ? j : 0; }
            if (tid < 4) nsel[rowbase + t0 + tid] = t0 + tid + 1;
            continue;
        }
        if (!havepf) IDX_FRAGS(gq);
#pragma unroll
        for (int rg = 0; rg < 2; ++rg)
#pragma unroll
            for (int ks = 0; ks < 4; ++ks) { const u32x4 w = __builtin_bit_cast(u32x4, Af[rg][ks]);
                Af8[rg][2 * ks] = (int)pk4_fp8(bflo(w.x) * IDX_QS, bfhi(w.x) * IDX_QS, bflo(w.y) * IDX_QS, bfhi(w.y) * IDX_QS); Af8[rg][2 * ks + 1] = (int)pk4_fp8(bflo(w.z) * IDX_QS, bfhi(w.z) * IDX_QS, bflo(w.w) * IDX_QS, bfhi(w.w) * IDX_QS); }
        float mn[2] = {INFINITY, INFINITY}, mx[2] = {-INFINITY, -INFINITY};
        const int ntile = (t0 + 4 + 31) >> 5;
        const unsigned char* kf = kfrag + (size_t)b * 256 * 2048 + lane * 16;
#define IDX_LOAD(B, kt0) do { _Pragma("unroll") for (int j_ = 0; j_ < IDX_NB; ++j_) { int kt_ = (kt0) + 8 * j_; kt_ = kt_ < ntile ? kt_ : ntile - 1; \
            _Pragma("unroll") for (int kp_ = 0; kp_ < 2; ++kp_) B[j_][kp_] = *(const u32x4*)(kf + ((size_t)kt_ * 2 + kp_) * 1024); } } while (0)
#define IDX_DUMP ((155648 + 1024) / 4)
#define IDX_RELU(x) __builtin_amdgcn_fmed3f((x), 0.0f, 3.0e38f)
#define IDX_PK(lo, hi_) __builtin_bit_cast(unsigned, __builtin_convertvector((f32x2){IDX_RELU(lo), IDX_RELU(hi_)}, bf16x2_t))
#define IDX_ONE(Bj, kt_, rg_) do { const int key_ = (kt_) * 32 + r32; f32x16 a0_ = {}; \
                a0_ = __builtin_amdgcn_mfma_scale_f32_32x32x64_f8f6f4(Af8[rg_], __builtin_bit_cast(v8i_t, __builtin_shufflevector(Bj[0], Bj[1], 0, 1, 2, 3, 4, 5, 6, 7)), a0_, 0, 0, 0, 0x7F7F7F7F, 0, 0x7F7F7F7F);     \
                  \
                  \
                float sd_ = 0.f; const u32x4 wa_ = __builtin_bit_cast(u32x4, Wp[rg_][0]), wb_ = __builtin_bit_cast(u32x4, Wp[rg_][1]); \
                const unsigned wv_[8] = {wa_.x, wa_.y, wa_.z, wa_.w, wb_.x, wb_.y, wb_.z, wb_.w}; \
                _Pragma("unroll") for (int i_ = 0; i_ < 8; ++i_) { const s16x2_t p_ = __builtin_elementwise_max(__builtin_bit_cast(s16x2_t, __builtin_convertvector((f32x2){a0_[2 * i_], a0_[2 * i_ + 1]}, bf16x2_t)), (s16x2_t){0, 0}); \
                    sd_ = __builtin_amdgcn_fdot2_f32_bf16(__builtin_bit_cast(bf16x2_t, p_), __builtin_bit_cast(bf16x2_t, wv_[i_]), sd_, false); } \
                const float s0_ = sd_ * 0.03125f; \
                { const bool ok_ = key_ <= t0 + 2 * rg_ + hi;     \
                  Sc[ok_ ? (2 * rg_ + hi) * 8192 + key_ : IDX_DUMP] = s0_; mn[rg_] = fminf(mn[rg_], ok_ ? s0_ : INFINITY); mx[rg_] = fmaxf(mx[rg_], ok_ ? s0_ : -INFINITY); } } while (0)
#define IDX_COMP(B, kt0) do { if ((kt0) + 8 < ntile) { IDX_ONE(B[0], (kt0), 0); IDX_ONE(B[1], (kt0) + 8, 0); IDX_ONE(B[0], (kt0), 1); IDX_ONE(B[1], (kt0) + 8, 1); } \
            else if ((kt0) < ntile) { IDX_ONE(B[0], (kt0), 0); IDX_ONE(B[0], (kt0), 1); } } while (0)
#if defined(PROBE_SCORE2)
        for (int rep_ = 0; rep_ < 2; ++rep_)
#endif
        {
            u32x4 Ba[IDX_NB][2], Bb[IDX_NB][2];
            int kt0 = wave;
            IDX_LOAD(Ba, kt0);
            while (kt0 < ntile) {
                IDX_LOAD(Bb, kt0 + 8 * IDX_NB); IDX_COMP(Ba, kt0); kt0 += 8 * IDX_NB;
                if (kt0 >= ntile) break;
                IDX_LOAD(Ba, kt0 + 8 * IDX_NB); IDX_COMP(Bb, kt0); kt0 += 8 * IDX_NB;
            }
        }
#undef IDX_LOAD
#undef IDX_COMP
#undef IDX_ONE
#undef IDX_PK
#undef IDX_DUMP
#undef IDX_RELU
        { const int gn = gq + G; havepf = (gn < T / 4) && (((gn & 2047) * 4) >= 256); if (havepf) IDX_FRAGS(gn); }
#pragma unroll
        for (int rg = 0; rg < 2; ++rg) {
            __hip_atomic_fetch_min(mm + 2 * (2 * rg + hi), F2ORD(mn[rg]), __ATOMIC_RELAXED, __HIP_MEMORY_SCOPE_WORKGROUP);
            __hip_atomic_fetch_max(mm + 2 * (2 * rg + hi) + 1, F2ORD(mx[rg]), __ATOMIC_RELAXED, __HIP_MEMORY_SCOPE_WORKGROUP);
        }
        float cva[16], cvb[16], cvc[16], cvd[16], cve[16], cvf[16];
        CVT_ISSUE(cva, cj);
        __syncthreads();
        int ln = lane; asm volatile("" : "+v"(ln));
        const int q = wave >> 1, P = wave & 1, nq = t0 + q + 1, nch = (nq + 63) >> 6;
        const int nh = (nch + 1) >> 1, cbeg = P * nh, cend = (cbeg + nh < nch) ? cbeg + nh : nch;
        const int imn_ = mm[2 * q], imx_ = mm[2 * q + 1];
        const float vmin = __int_as_float(imn_ ^ ((imn_ >> 31) & 0x7fffffff)), vmax = __int_as_float(imx_ ^ ((imx_ >> 31) & 0x7fffffff));
        const float range = vmax - vmin; const float kscale = range > 0.f ? 1048576.0f / range : 0.f;
        LAS float* Sq = Sc + q * 8192; LAS int* Kq = (LAS int*)Sq; LAS unsigned* h1q = hist1 + q * 1024;
#define P1_ELEM(v_, s_) do { int k_ = (int)(((v_) - vmin) * kscale); k_ = k_ < 0 ? 0 : k_; k_ = k_ > 1048575 ? 1048575 : k_; Kq[(s_)] = k_; \
            __hip_atomic_fetch_add(h1q + (k_ >> 10), 1u, __ATOMIC_RELAXED, __HIP_MEMORY_SCOPE_WORKGROUP); } while (0)
        const int nfull = nq >> 6;
        const int cfe = cend < nfull ? cend : nfull;
        { int c = cbeg;
          for (; c + 4 <= cfe; c += 4) { float v_[4];
#pragma unroll
              for (int u = 0; u < 4; ++u) v_[u] = Sq[64 * (c + u) + ln];
#pragma unroll
              for (int u = 0; u < 4; ++u) P1_ELEM(v_[u], 64 * (c + u) + ln); }
          for (; c < cfe; ++c) { const float v1_ = Sq[64 * c + ln]; P1_ELEM(v1_, 64 * c + ln); }
          for (; c < cend; ++c) { const int s = 64 * c + ln; if (s < nq) { const float v1_ = Sq[s]; P1_ELEM(v1_, s); } } }
#undef P1_ELEM
        CVT_ISSUE(cvb, cj + 1); CVT_ISSUE(cvc, cj + 2);
        __syncthreads();
        int B1; unsigned cgt1;
        { unsigned h_[16];
          const u32x4 h0 = *(const LAS u32x4*)(h1q + 16 * ln), h1v = *(const LAS u32x4*)(h1q + 16 * ln + 4), h2v = *(const LAS u32x4*)(h1q + 16 * ln + 8), h3v = *(const LAS u32x4*)(h1q + 16 * ln + 12);
          h_[0] = h0.x; h_[1] = h0.y; h_[2] = h0.z; h_[3] = h0.w; h_[4] = h1v.x; h_[5] = h1v.y; h_[6] = h1v.z; h_[7] = h1v.w; h_[8] = h2v.x; h_[9] = h2v.y; h_[10] = h2v.z; h_[11] = h2v.w; h_[12] = h3v.x; h_[13] = h3v.y; h_[14] = h3v.z; h_[15] = h3v.w;
          unsigned tot_ = 0;
#pragma unroll
          for (int j_ = 0; j_ < 16; ++j_) tot_ += h_[j_];
          unsigned suf_ = tot_;
#pragma unroll
          for (int o_ = 1; o_ < 64; o_ <<= 1) { const unsigned t_ = __shfl_down(suf_, o_); if (ln + o_ < 64) suf_ += t_; }
          unsigned cum_ = suf_ - tot_; int bin_ = -1; unsigned cg_ = 0;
#pragma unroll
          for (int j_ = 15; j_ >= 0; --j_) { const bool hit_ = (bin_ < 0) && (cum_ + h_[j_] >= 256u); if (hit_) { bin_ = 16 * ln + j_; cg_ = cum_; } cum_ += h_[j_]; }
          const bool mine_ = (suf_ - tot_) < 256u && 256u <= suf_; const unsigned long long mk_ = __ballot(mine_);
          const int src_ = mk_ ? (int)__builtin_ctzll(mk_) : 0; B1 = __shfl(bin_, src_); cgt1 = (unsigned)__shfl((int)cg_, src_); if (!mk_) { B1 = 0; cgt1 = 0; } }
        CVT_ISSUE(cvd, cj + 3); CVT_ISSUE(cve, cj + 4);
        const unsigned r1 = 256u - cgt1;
        int* outp = sel + (size_t)(rowbase + t0 + q) * 256;
        const unsigned long long ltmask = (1ull << ln) - 1ull, gtmask = ~((2ull << ln) - 1ull);
        unsigned run = 0;
#define P2_CHUNK(K_, s_) do { const int kb_ = (K_) < 0 ? -1 : ((K_) >> 10); const bool em_ = kb_ > B1, cd_ = kb_ == B1; \
            const unsigned long long me_ = __ballot(em_); \
            if (me_) { const unsigned pos_ = P ? (cgt1 - 1u - run - (unsigned)__builtin_popcountll(me_ & gtmask)) : (run + (unsigned)__builtin_popcountll(me_ & ltmask)); \
                if (em_ && pos_ < 256u) outp[pos_] = (s_); run += (unsigned)__builtin_popcountll(me_); } \
            const unsigned long long mc_ = __ballot(cd_); \
            if (mc_) { unsigned base_ = 0; if (ln == 0) base_ = __hip_atomic_fetch_add(cnts + q, (unsigned)__builtin_popcountll(mc_), __ATOMIC_RELAXED, __HIP_MEMORY_SCOPE_WORKGROUP); \
                base_ = __builtin_amdgcn_readfirstlane(base_); const unsigned pos_ = base_ + (unsigned)__builtin_popcountll(mc_ & ltmask); \
                if (cd_ && pos_ < 256u) { cand[(q * 256 + pos_) * 2] = (s_); cand[(q * 256 + pos_) * 2 + 1] = (K_); } } } while (0)
        if (P == 0) {
            int c = cbeg;
            for (; c + 4 <= cend; c += 4) { int k_[4];
#pragma unroll
                for (int u = 0; u < 4; ++u) k_[u] = Kq[64 * (c + u) + ln];
#pragma unroll
                for (int u = 0; u < 4; ++u) P2_CHUNK(k_[u], 64 * (c + u) + ln); }
            for (; c < cend; ++c) { const int k1_ = Kq[64 * c + ln]; P2_CHUNK(k1_, 64 * c + ln); }
        } else {
            int c = cend - 1;
            if (c >= cbeg && c >= nfull) { const int s = 64 * c + ln; const int k1_ = (s < nq) ? Kq[64 * (c & 127) + ln] : -1; P2_CHUNK(k1_, s); --c; }
            for (; c - 3 >= cbeg; c -= 4) { int k_[4];
#pragma unroll
                for (int u = 0; u < 4; ++u) k_[u] = Kq[64 * (c - u) + ln];
#pragma unroll
                for (int u = 0; u < 4; ++u) P2_CHUNK(k_[u], 64 * (c - u) + ln); }
            for (; c >= cbeg; --c) { const int k1_ = Kq[64 * c + ln]; P2_CHUNK(k1_, 64 * c + ln); }
        }
#undef P2_CHUNK
        CVT_ISSUE(cvf, cj + 5);
        __syncthreads();
        if (P == 0) {
            const unsigned nc = cnts[q] < 256u ? cnts[q] : 256u;
            const unsigned take = r1 < nc ? r1 : nc;
            for (int m4 = 0; m4 < 4; ++m4) { const unsigned i = ln + 64 * m4; if (i < nc) { const int myi = cand[(q * 256 + i) * 2], myk = cand[(q * 256 + i) * 2 + 1]; unsigned rank = 0;
                    for (unsigned j = 0; j < nc; ++j) { const int oi = cand[(q * 256 + j) * 2], ok = cand[(q * 256 + j) * 2 + 1]; rank += (ok > myk || (ok == myk && oi < myi)) ? 1u : 0u; }
                    if (rank < take) outp[cgt1 + rank] = myi; } }
            if (ln == 0) nsel[rowbase + t0 + q] = (int)(cgt1 + take);
            LDS_WAIT();
            if (ln == 0) { cnts[q] = 0u; mm[2 * q] = 0x7fffffff; mm[2 * q + 1] = (int)0x80000000; }
        }
        for (int i = tid; i < 4096; i += NTHREADS) hist1[i] = 0u;
        CVT_DONE(cva, cj); CVT_DONE(cvb, cj + 1); CVT_DONE(cvc, cj + 2); CVT_DONE(cvd, cj + 3); CVT_DONE(cve, cj + 4); CVT_DONE(cvf, cj + 5); cj = (cj + 6 < CVT_ITEMS) ? cj + 6 : CVT_ITEMS;
        __syncthreads();
    }
    for (; cj < CVT_ITEMS; cj += 2) { float cva[16], cvb[16]; CVT_ISSUE(cva, cj); CVT_ISSUE(cvb, cj + 1); CVT_DONE(cva, cj); CVT_DONE(cvb, cj + 1); }
}
#undef IDX_FRAGS
#undef F2ORD

__device__ __forceinline__ void sattn_phase(const unsigned char* ckv, const bf16* qlat, bf16* olat, const int* sel, const int* nsel, const int* positions, const float* rel_bias, lds_t* lds, const int tid, const int lane, const int wave, const int gw, const int NGW) {
    typedef __bf16 bf16x2_t __attribute__((ext_vector_type(2)));
    lds_t* buf = lds + wave * 16384;
    LAS unsigned char* bkb = (LAS unsigned char*)(lds + 131072 + wave * 256);
    LAS float* btab = (LAS float*)(lds + 131072 + 2048);
    if (tid < 256) btab[tid] = rel_bias[tid] * LOG2E;
    __syncthreads();
    const int head = lane & 15, g = lane >> 4, m15 = lane & 15;
    DECL_TRB(trb);
    unsigned wro[2][4];
    if (gw >= T) return;
    int cntN = nsel[gw], posqN = positions[gw]; int selN[4];
#pragma unroll
    for (int m4 = 0; m4 < 4; ++m4) selN[m4] = sel[(size_t)gw * 256 + lane + 64 * m4];
    (void)wro;
    for (int qi = gw; qi < T; qi += NGW) {
        const int b = qi >> 13; const int rowbase = b * SEQ;
        const int cnt = cntN, posq = posqN; const int nchunk = (cnt + 31) >> 5;
        int selv[4];
#pragma unroll
        for (int m4 = 0; m4 < 4; ++m4) selv[m4] = (lane + 64 * m4 < cnt) ? selN[m4] : 0;
        { const int qn = (qi + NGW < T) ? qi + NGW : qi;
          cntN = nsel[qn]; posqN = positions[qn];
#pragma unroll
          for (int m4 = 0; m4 < 4; ++m4) selN[m4] = sel[(size_t)qn * 256 + lane + 64 * m4]; }
        int pk[4];
#pragma unroll
        for (int m4 = 0; m4 < 4; ++m4) pk[m4] = positions[rowbase + selv[m4]];
#define SA_GATHER(RAW, ch_) do { const int chc_ = (ch_) < nchunk ? (ch_) : nchunk - 1; \
            const int v01_ = (chc_ & 2) ? selv[1] : selv[0], v23_ = (chc_ & 2) ? selv[3] : selv[2]; const int vv_ = (chc_ & 4) ? v23_ : v01_; \
            _Pragma("unroll") for (int rb_ = 0; rb_ < 2; ++rb_) { const int row_ = 8 * (m15 >> 2) + 4 * rb_ + (m15 & 3); const int idx_ = __shfl(vv_, (chc_ & 1) * 32 + row_); \
                const unsigned char* rp_ = ckv + (size_t)(rowbase + idx_) * 256 + 16 * g; \
                _Pragma("unroll") for (int j_ = 0; j_ < 4; ++j_) RAW[rb_][j_] = *(const u32x4*)(rp_ + 64 * j_); } } while (0)
        u32x4 rawA[2][4], rawB[2][4];
        SA_GATHER(rawA, 0);
#pragma unroll
        for (int m4 = 0; m4 < 4; ++m4) bkb[lane + 64 * m4] = (unsigned char)t5_bucket(posq - pk[m4]);
        bf16x8 Qf[8];
#pragma unroll
        for (int s = 0; s < 8; ++s) { Qf[s] = (bf16x8){0, 0, 0, 0, 0, 0, 0, 0}; if (head < 8) Qf[s] = *(const bf16x8*)(qlat + (size_t)qi * 2048 + head * 256 + 64 * (s >> 1) + 16 * g + 8 * (s & 1)); }
        float m_run = -INFINITY, l_run = 0.f;
        f32x4 oacc[16];
#pragma unroll
        for (int c = 0; c < 16; ++c) oacc[c] = (f32x4){0.f, 0.f, 0.f, 0.f};
#define SA_CVT(w_) ((unsigned)__builtin_bit_cast(unsigned, __builtin_amdgcn_cvt_scalef32_pk_bf16_fp8((int)(w_), 1.0f, false))), ((unsigned)__builtin_bit_cast(unsigned, __builtin_amdgcn_cvt_scalef32_pk_bf16_fp8((int)(w_), 1.0f, true)))
#define SA_CHUNK(RAW, ch) do { \
            f32x4 sc[2]; \
            _Pragma("unroll") for (int rb = 0; rb < 2; ++rb) { sc[rb] = (f32x4){0.f, 0.f, 0.f, 0.f}; const unsigned row = 8u * (m15 >> 2) + 4u * rb + (m15 & 3); \
                _Pragma("unroll") for (int j = 0; j < 4; ++j) { \
                    const u32x4 f0 = (u32x4){SA_CVT(RAW[rb][j].x), SA_CVT(RAW[rb][j].y)}, f1 = (u32x4){SA_CVT(RAW[rb][j].z), SA_CVT(RAW[rb][j].w)}; \
                    const unsigned chn = 8u * j + 2u * g; lds_t* im = buf + (chn >> 4) * 8192; \
                    *(LAS u32x4*)(im + off_b(row, chn & 15u)) = f0; *(LAS u32x4*)(im + off_b(row, (chn & 15u) + 1u)) = f1; \
                    sc[rb] = __builtin_amdgcn_mfma_f32_16x16x32_bf16(__builtin_bit_cast(bf16x8, f0), Qf[2 * j], sc[rb], 0, 0, 0); \
                    sc[rb] = __builtin_amdgcn_mfma_f32_16x16x32_bf16(__builtin_bit_cast(bf16x8, f1), Qf[2 * j + 1], sc[rb], 0, 0, 0); } } \
            const unsigned long long bk8 = *(const LAS unsigned long long*)(bkb + (ch) * 32 + 8 * g); \
            float sv[8]; float cmax = -INFINITY; \
            _Pragma("unroll") for (int rb = 0; rb < 2; ++rb) _Pragma("unroll") for (int r = 0; r < 4; ++r) { const int j8 = 4 * rb + r; const int kidx = (ch) * 32 + 8 * g + j8; const unsigned bkt = (unsigned)(bk8 >> (8 * j8)) & 0xffu; \
                    (void)kidx; sv[j8] = sc[rb][r] * (LOG2E / CKV_S) + btab[(bkt & 31u) * 8 + (head & 7)]; } \
            if ((ch) == nchunk - 1) { _Pragma("unroll") for (int j8 = 0; j8 < 8; ++j8) sv[j8] = ((ch) * 32 + 8 * g + j8 < cnt) ? sv[j8] : -INFINITY; }     \
            _Pragma("unroll") for (int j8 = 0; j8 < 8; ++j8) cmax = fmaxf(cmax, sv[j8]); \
            cmax = fmaxf(cmax, __shfl_xor(cmax, 16)); cmax = fmaxf(cmax, __shfl_xor(cmax, 32)); \
            const float m_new = fmaxf(m_run, cmax); const float m_use = (m_new == -INFINITY) ? 0.f : m_new; \
            const float alpha = __builtin_amdgcn_exp2f(m_run - m_use); \
            float ps = 0.f; float p[8]; \
            _Pragma("unroll") for (int j8 = 0; j8 < 8; ++j8) { p[j8] = __builtin_amdgcn_exp2f(sv[j8] - m_use); ps += p[j8]; } \
            l_run = l_run * alpha + ps; \
            if (!__all(m_new == m_run)) { _Pragma("unroll") for (int c = 0; c < 16; ++c) oacc[c] = oacc[c] * alpha; }     \
            m_run = m_new; \
            const u32x4 pw = (u32x4){pk2(p[0], p[1]), pk2(p[2], p[3]), pk2(p[4], p[5]), pk2(p[6], p[7])}; \
            const bf16x8 Pf = __builtin_bit_cast(bf16x8, pw); \
            asm volatile("s_waitcnt lgkmcnt(0)" ::: "memory"); \
            _Pragma("unroll") for (int c = 0; c < 16; ++c) { const lds_t* im = buf + (c >> 3) * 8192; \
                const bf16x8 A = cat4(tr_read(im + trb[0][c & 7]), tr_read(im + trb[1][c & 7])); \
                oacc[c] = __builtin_amdgcn_mfma_f32_16x16x32_bf16(A, Pf, oacc[c], 0, 0, 0); } \
            asm volatile("s_waitcnt lgkmcnt(0)" ::: "memory"); \
            __builtin_amdgcn_sched_barrier(0); } while (0)
        for (int ch = 0; ch < nchunk; ch += 2) {
            SA_GATHER(rawB, ch + 1);
            SA_CHUNK(rawA, ch);
            if (ch + 1 >= nchunk) break;
            SA_GATHER(rawA, ch + 2);
            SA_CHUNK(rawB, ch + 1);
        }
#undef SA_GATHER
#undef SA_CHUNK
#undef SA_CVT
        float lt = l_run; lt += __shfl_xor(lt, 16); lt += __shfl_xor(lt, 32);
        const float inv = (1.0f / CKV_S) / lt;
        if (head < 8) {
            bf16* op = olat + (size_t)qi * 2048 + head * 256 + 4 * g;
#pragma unroll
            for (int c = 0; c < 16; ++c) { const f32x4 o = oacc[c] * inv; *(u32x2*)(op + 16 * c) = (u32x2){pk2(o[0], o[1]), pk2(o[2], o[3])}; }
        }
    }
}

__global__ void __launch_bounds__(NTHREADS, 2) fwd_kernel(Args a) {
    extern __shared__ __attribute__((aligned(16))) unsigned char lds_raw[];
    lds_t* lds = (lds_t*)lds_raw;
    volatile LAS unsigned* MISC = (volatile LAS unsigned*)(lds + MISC_OFF);
    int tid = threadIdx.x, lane = tid & 63; const int wave = __builtin_amdgcn_readfirstlane(tid >> 6);
    const int G = gridDim.x, bx = blockIdx.x;
    const int gw = bx * NWAVES + wave, NGW = G * NWAVES;
    unsigned char* ws = a.ws;
    unsigned* ctl = (unsigned*)(ws + WS_CTL);
    if (tid < 64) MISC[tid] = 0u;
    __syncthreads();
    XcdBarrier bar; bar.bar = ctl + CW_BAR; bar.x = 0; bar.st = nullptr;
    if (a.use_bar) bar = xcd_barrier_post(ctl + CW_BAR, MISC + 8);
    const int lo = a.ph_lo, hi = a.ph_hi;
#ifndef PH_MASK
#define PH_MASK 0xFFFF
#endif
#define IN(k) (((PH_MASK >> (k)) & 1) && lo <= (k) && (k) < hi)
#define SEAM(k) do { if (IN(k) && IN((k) + 1)) xcd_barrier(bar); asm volatile("" : "+v"(tid)); lane = tid & 63; } while (0)

#define w_inT ((bf16*)(ws + WS_WIN_T))
#define w_outT ((bf16*)(ws + WS_WOUT_T))
#define w_cqT ((bf16*)(ws + WS_WCQ_T))
#define w_ckvT ((bf16*)(ws + WS_WCKV_T))
#define w_coT ((bf16*)(ws + WS_WCO_T))
#define w_ukb ((bf16*)(ws + WS_WUK))
#define w_uvP ((bf16*)(ws + WS_WUVP))
#define w_gu8 (ws + WS_WGU_T)
#define w_d8 (ws + WS_WD_T)
#define hn ((bf16*)(ws + WS_HN))
#define memn ((bf16*)(ws + WS_MEMN))
#define kvc ((bf16*)(ws + WS_KVC))
#define qc ((bf16*)(ws + WS_QC))
#define oc ((bf16*)(ws + WS_OC))
#define proj ((bf16*)(ws + X_PROJ))
#define qlat ((bf16*)(ws + X_QLAT))
#define sel ((int*)(ws + X_SEL))
#define nsel ((int*)(ws + X_NSEL))
#define kvbuf ((float*)(ws + X_KV))
#define rprev ((bf16*)(ws + X_RPREV))
#define mix ((bf16*)(ws + X_MIX))
#define rope ((float*)(ws + X_ROPE))
#define olat ((bf16*)(ws + X_OLAT))
#define kfrag ((unsigned char*)(ws + X_KFRAG))
#define ckv8 (ws + X_CKV8)
#define hres ((bf16*)(ws + WS_HRES))
#define asort (ws + X_ASORT)
#define hmid (ws + X_HMID)
#define ybuf ((bf16*)(ws + X_Y))
#define tok_e ((int*)(ws + R_TOKE))
#define tok_pos ((int*)(ws + R_TOKPOS))
#define tok_gate ((float*)(ws + R_TOKGATE))
#define tok_slot ((int*)(ws + R_TOKSLOT))
#define slot_gate ((float*)(ws + R_SLOTGATE))
#define slot_tok ((int*)(ws + R_SLOTTOK))
#define slot_rstd ((float*)(ws + WS_SLOTRSTD))
#define ssq2 ((const float*)(ws + WS_SSQ2))
    const bool cvt_in_idx = (G == 256);
    if (IN(0)) {
        LAS float* scr = (LAS float*)(lds + wave * 16896);
        for (int it = gw; it < 32 * (NPROJ / 32); it += NGW) { const int kb = it / (NPROJ / 32), nb = it % (NPROJ / 32);
            transpose_item(a.w_in, IN_WIDTH, w_inT, DM, 64 * kb, 32 * nb, scr, lane, [](int n) { return n < 2384 ? n : (n < 2560 ? -1 : n - 176); }); }
        for (int it = gw; it < 32 * 64; it += NGW) { const int kb = it / 64, nb = it % 64; transpose_item(a.w_out, DM, w_outT, DM, 64 * kb, 32 * nb, scr, lane, [](int n) { return n; }); }
        for (int it = gw; it < 32 * 16; it += NGW) { const int kb = it / 16, nb = it % 16; transpose_item(a.w_cq, 512, w_cqT, DM, 64 * kb, 32 * nb, scr, lane, [](int n) { return n; }, a.norm_cross); }
        for (int it = gw; it < 32 * 16; it += NGW) { const int kb = it / 16, nb = it % 16; transpose_item(a.w_ck, 512, w_ckvT, DM, 64 * kb, 32 * nb, scr, lane, [](int n) { return n; }); }
        for (int it = gw; it < 32 * 16; it += NGW) { const int kb = it / 16, nb = it % 16; transpose_item(a.w_cv, 512, w_ckvT + (size_t)512 * DM, DM, 64 * kb, 32 * nb, scr, lane, [](int n) { return n; }); }
        for (int it = gw; it < 8 * 64; it += NGW) { const int kb = it / 64, nb = it % 64; transpose_item(a.w_co, DM, w_coT, 512, 64 * kb, 32 * nb, scr, lane, [](int n) { return n; }); }
        for (int it = gw; it < 4 * 8 * 8; it += NGW) { const int p = it >> 6, kb = (it >> 3) & 7, nb = it & 7;
            const int nhalf = nb >> 2, khalf = kb >> 2;
            const int head = 2 * p + nhalf; const bool nz = (nhalf == khalf);
            transpose_item(a.w_uv + (size_t)(64 * (kb & 3)) * 1024, 1024, w_uvP + (size_t)p * 256 * 512 + 64 * kb, 512, 0, 32 * nb, scr, lane,
                           [=](int n) { return nz ? head * 128 + (n & 127) : -1; }); }
        for (int i = gw * 64 + lane; i < 2048 * 256 / 4; i += NGW * 64) { const int row = i >> 6, k4 = (i & 63) * 4, h = row >> 8, c = row & 255;
            f32x4 v = (f32x4){0.f, 0.f, 0.f, 0.f}; if ((k4 >> 7) == (h & 1)) v = *(const f32x4*)(a.w_uk + (size_t)c * 1024 + h * 128 + (k4 & 127));
            ((u32x2*)w_ukb)[i] = (u32x2){pk2(v.x, v.y), pk2(v.z, v.w)}; }
        if (!cvt_in_idx) { LAS float* scr8 = (LAS float*)(lds + wave * 16896);
          auto gu_map = [](int n) { return ((n & 255) < 128) ? 128 * (n >> 8) + (n & 127) : DFF + 128 * (n >> 8) + (n & 127); };
          auto id_map = [](int n) { return n; };
          constexpr int N_GU = NE * 2048, N_DN = NE * 1024;
#define T8_LOAD(V, it_) do { const int itc_ = (it_) < N_GU + N_DN ? (it_) : N_GU + N_DN - 1; \
              if (itc_ < N_GU) { const int e_ = itc_ >> 11, r_ = itc_ & 2047; t8_load(V, a.w_gu + (size_t)e_ * DM * 2 * DFF, 2 * DFF, 128 * (r_ >> 7), 32 * (r_ & 127), lane, gu_map); } \
              else { const int i2_ = itc_ - N_GU, e_ = i2_ >> 10, r_ = i2_ & 1023; t8_load(V, a.w_down + (size_t)e_ * DFF * DM, DM, 128 * (r_ >> 6), 32 * (r_ & 63), lane, id_map); } } while (0)
#define T8_FIN(V, it_) do { if ((it_) < N_GU) { const int e_ = (it_) >> 11, r_ = (it_) & 2047; t8_finish(V, w_gu8 + (size_t)e_ * 2 * DFF * DM, DM, 128 * (r_ >> 7), 32 * (r_ & 127), scr8, lane, FP8_WS); } \
              else { const int i2_ = (it_) - N_GU, e_ = i2_ >> 10, r_ = i2_ & 1023; t8_finish(V, w_d8 + (size_t)e_ * DM * DFF, DFF, 128 * (r_ >> 6), 32 * (r_ & 63), scr8, lane, FP8_WS); } } while (0)
          f32x4 va[16], vb[16];
          int it = gw;
          if (it < N_GU + N_DN) T8_LOAD(va, it);
          while (it < N_GU + N_DN) {
              T8_LOAD(vb, it + NGW); T8_FIN(va, it); it += NGW;
              if (it >= N_GU + N_DN) break;
              T8_LOAD(va, it + NGW); T8_FIN(vb, it); it += NGW;
          }
#undef T8_LOAD
#undef T8_FIN
        }
        for (int m = gw; m < T; m += NGW) rms_row_bf16(a.x + (size_t)m * DM, a.norm_mix, hn + (size_t)m * DM, lane);
        for (int m = gw; m < BATCH * NMEM; m += NGW) rms_row_bf16(a.mem + (size_t)m * DM, a.norm_mem, memn + (size_t)m * DM, lane);
        for (int i = gw * 64 + lane; i < T * 64; i += NGW * 64) { const int t = i >> 6, f = i & 63;
            const float inv = powf(10000.0f, -(float)(2 * f) / 128.0f); const float ang = (float)a.positions[t] * inv; float sn, cs; sincosf(ang, &sn, &cs);
            ((f32x2*)rope)[i] = (f32x2){cs, sn}; }
    }
    SEAM(0);

    if (IN(1)) {
        { pg8::DenseSched S; S.a_sh = 0; S.r_pm = 0; S.r_pn = 0; S.nM = T / 256; S.nN = NPROJ / 256; S.nwg = S.nM * S.nN; S.G = G; S.c = bx;
          S.A0 = (const char*)hn; S.B0 = (const char*)w_inT; S.C0 = (char*)proj; S.R0 = nullptr;
          S.a_pm = 256L * DM * 2; S.a_pn = 0; S.b_pn = 256L * DM * 2; S.c_pm = 256L * NPROJ * 2; S.c_pn = 512;
          pg8::EpiBf16S E{NPROJ, 1.0f};
          pg8::gemm_phase<pg8::EpiBf16S, pg8::DenseSched, true>(lds, DM, DM, DM, S, E); }
    }
    SEAM(1);

    if (IN(2)) {
        const int nkv = (G > 32) ? 16 : 0;
        if (bx < 16 || nkv == 0) { pg8::DenseSched S; S.a_sh = 0; S.r_pm = 0; S.r_pn = 0; S.nM = 4; S.nN = 4; S.nwg = 16; S.G = G; S.c = bx;
          S.A0 = (const char*)memn; S.B0 = (const char*)w_ckvT; S.C0 = (char*)kvc; S.R0 = nullptr;
          S.a_pm = 256L * DM * 2; S.a_pn = 0; S.b_pn = 256L * DM * 2; S.c_pm = 256L * 1024 * 2; S.c_pn = 512;
          pg8::EpiBf16S E{1024, 1.0f};
          pg8::gemm_phase<pg8::EpiBf16S, pg8::DenseSched, true>(lds, DM, DM, DM, S, E); }
        if (bx >= nkv)
        for (int m = (bx - nkv) * NWAVES + wave; m < T; m += (G - nkv) * NWAVES) {
            bf16* row = proj + (size_t)m * NPROJ;
            { u32x2 w = *((const u32x2*)(row + C_CKV) + lane); float v0 = bflo(w.x), v1 = bfhi(w.x), v2 = bflo(w.y), v3 = bfhi(w.y);
              const float rstd = rsqrtf(wave_sum(v0 * v0 + v1 * v1 + v2 * v2 + v3 * v3) * (1.f / 256.f) + EPS); const f32x4 g = ((const f32x4*)a.kv_norm)[lane];
              *((unsigned*)(ckv8 + (size_t)m * 256) + lane) = pk4_fp8(v0 * rstd * g.x * CKV_S, v1 * rstd * g.y * CKV_S, v2 * rstd * g.z * CKV_S, v3 * rstd * g.w * CKV_S); }
            { const float v = bf2f(row[C_KIDX + lane]); const float rstd = rsqrtf(wave_sum(v * v) * (1.f / 64.f) + EPS);
              const int bb = m >> 13, key = m & 8191, d = lane;
              const float kv = __builtin_amdgcn_fmed3f(v * rstd * a.idx_k_norm[lane] * IDX_KS, -448.0f, 448.0f);
              kfrag[((((size_t)(bb * 256 + (key >> 5)) * 2 + ((d >> 4) & 1)) * 64) + (d >> 5) * 32 + (key & 31)) * 16 + (d & 15)] = (unsigned char)(__builtin_amdgcn_cvt_pk_fp8_f32(kv, kv, 0, false) & 0xff); }
        }
    }
    SEAM(2);

    if (IN(3)) {
        { pg8::DenseSched S; S.a_sh = 0; S.r_pm = 0; S.r_pn = 0; S.nM = T / 256; S.nN = 8; S.nwg = S.nM * 8; S.G = G; S.c = bx;
          S.A0 = (const char*)(proj + C_QATT); S.B0 = (const char*)w_ukb; S.C0 = (char*)qlat; S.R0 = nullptr; S.a_sh = 1;
          S.a_pm = 256L * NPROJ * 2; S.a_pn = 512; S.b_pn = 256L * 256 * 2; S.c_pm = 256L * 2048 * 2; S.c_pn = 512;
          pg8::EpiBf16S E{2048, 0.08838834764831845f};
          pg8::gemm_phase<pg8::EpiBf16S, pg8::DenseSched, true>(lds, 256, NPROJ, 256, S, E); }
        __syncthreads();
        idx_phase(proj, kfrag, sel, nsel, lds, tid, lane, wave, bx, G, cvt_in_idx, a.w_gu, a.w_down, w_gu8, w_d8);
#if defined(PROBE_IDX2)
        __syncthreads(); idx_phase(proj, kfrag, sel, nsel, lds, tid, lane, wave, bx, G, cvt_in_idx, a.w_gu, a.w_down, w_gu8, w_d8);
#endif
        __syncthreads();
        {
            lds_t* kimg = lds;
            lds_t* vimg = lds + 32768;
            DECL_TRB(trb);
            unsigned trv[2][2];
#pragma unroll
            for (int i = 0; i < 2; ++i)
#pragma unroll
                for (int t = 0; t < 2; ++t) trv[i][t] = tr_addr16(lane, 0, (2 * wave + i) & 7, t) + (unsigned)((2 * wave + i) >> 3) * 32768u;
            for (int u = bx; u < 1024; u += G) {
                const int b = u >> 8, h = (u >> 6) & 3, c = u & 63; const int row0 = b * SEQ + c * 128;
                const float lg2 = log2f(1.0f - exp2f(-5.0f - (float)h));
                for (int it = tid; it < 1024; it += NTHREADS) { const int j = it >> 3, i0 = (it & 7) * 8;
                    const bf16* kp = proj + (size_t)(row0 + j) * NPROJ + C_KRET + h * 128 + i0;
                    const u32x4 x1 = *(const u32x4*)kp, x2 = *(const u32x4*)(kp + 64);
                    const float sc = 0.08838834764831845f * exp2f(lg2 * (float)(127 - j));
                    const f32x4* rp = (const f32x4*)(rope + ((size_t)(row0 + j) * 64 + i0) * 2);
                    const unsigned xa[4] = {x1.x, x1.y, x1.z, x1.w}, xb[4] = {x2.x, x2.y, x2.z, x2.w}; unsigned o1[4], o2[4];
#pragma unroll
                    for (int p = 0; p < 4; ++p) { const f32x4 cs = rp[p];
                        const float a0 = bflo(xa[p]), a1 = bfhi(xa[p]), b0 = bflo(xb[p]), b1 = bfhi(xb[p]);
                        o1[p] = pk2((a0 * cs.x - b0 * cs.y) * sc, (a1 * cs.z - b1 * cs.w) * sc); o2[p] = pk2((a0 * cs.y + b0 * cs.x) * sc, (a1 * cs.w + b1 * cs.z) * sc); }
                    *(LAS u32x4*)(kimg + off_b(j, i0 >> 3)) = (u32x4){o1[0], o1[1], o1[2], o1[3]};
                    *(LAS u32x4*)(kimg + off_b(j, 8 + (i0 >> 3))) = (u32x4){o2[0], o2[1], o2[2], o2[3]}; }
                { const char* vb = (const char*)(proj + (size_t)row0 * NPROJ + C_VRET + h * 256);
#pragma unroll
                  for (int i = 0; i < 8; ++i) { const int n = wave * 8 + i; const int j = 4 * (n & 31) + (lane >> 4), ch = (lane & 15) ^ ((((lane >> 4) & 3) << 2) | (n & 3));
                      __builtin_amdgcn_global_load_lds((const unsigned*)(vb + (size_t)j * (NPROJ * 2) + (n >> 5) * 256 + ch * 16), (LAS unsigned*)(vimg + (n >> 5) * 32768 + (n & 31) * 1024), 16, 0, 0); } }
                asm volatile("s_waitcnt vmcnt(0)" ::: "memory");
                __syncthreads();
                f32x4 acc[2][8];
#pragma unroll
                for (int i = 0; i < 2; ++i)
#pragma unroll
                    for (int d = 0; d < 8; ++d) acc[i][d] = (f32x4){0.f, 0.f, 0.f, 0.f};
#pragma unroll
                for (int ks = 0; ks < 4; ++ks) {
                    bf16x8 Av[2], Bk[8];
#pragma unroll
                    for (int i = 0; i < 2; ++i) Av[i] = cat4(tr_read(vimg + trv[i][0] + 8192 * ks), tr_read(vimg + trv[i][1] + 8192 * ks));
#pragma unroll
                    for (int d = 0; d < 8; ++d) Bk[d] = cat4(tr_read(kimg + trb[0][d] + 8192 * ks), tr_read(kimg + trb[1][d] + 8192 * ks));
#pragma unroll
                    for (int i = 0; i < 2; ++i)
#pragma unroll
                        for (int d = 0; d < 8; ++d) acc[i][d] = __builtin_amdgcn_mfma_f32_16x16x32_bf16(Av[i], Bk[d], acc[i][d], 0, 0, 0);
                }
                float* kvo = kvbuf + (size_t)u * 32768;
#pragma unroll
                for (int i = 0; i < 2; ++i)
#pragma unroll
                    for (int d = 0; d < 8; ++d)
#pragma unroll
                        for (int r = 0; r < 4; ++r) kvo[(size_t)(16 * (2 * wave + i) + 4 * (lane >> 4) + r) * 128 + 16 * d + (lane & 15)] = acc[i][d][r];
                __syncthreads();
            }
        }
    }
    SEAM(3);

    if (IN(4)) {
        for (int i = bx * NTHREADS + tid; i < 16 * 32768; i += G * NTHREADS) {
            const int bh = i >> 15, ed = i & 32767, h = bh & 3;
            const float cd = exp2f(128.0f * log2f(1.0f - exp2f(-5.0f - (float)h)));
            float R = 0.f;
            const float* src = kvbuf + (size_t)bh * 64 * 32768 + ed; bf16* dst = rprev + (size_t)bh * 64 * 32768 + ed;
            for (int c0 = 0; c0 < 64; c0 += 8) { float kv[8];
#pragma unroll
                for (int c = 0; c < 8; ++c) kv[c] = src[(size_t)(c0 + c) * 32768];
#pragma unroll
                for (int c = 0; c < 8; ++c) { dst[(size_t)(c0 + c) * 32768] = (bf16)f2bf(R); R = R * cd + kv[c]; } }
        }
        __syncthreads();
        sattn_phase(ckv8, qlat, olat, sel, nsel, a.positions, a.rel_bias, lds, tid, lane, wave, gw, NGW);
#if defined(PROBE_ATT2)
        __syncthreads(); sattn_phase(ckv8, qlat, olat, sel, nsel, a.positions, a.rel_bias, lds, tid, lane, wave, gw, NGW);
#endif
    }
    SEAM(4);

    if (IN(5)) {
        { pg8::DenseSched S; S.a_sh = 0; S.r_pm = 0; S.r_pn = 0; S.nM = T / 256; S.nN = 4; S.nwg = S.nM * 4; S.G = G; S.c = bx;
          S.A0 = (const char*)olat; S.B0 = (const char*)w_uvP; S.C0 = (char*)mix; S.R0 = nullptr;
          S.a_pm = 256L * 2048 * 2; S.a_pn = 1024; S.b_pn = 256L * 512 * 2; S.c_pm = 256L * 2048 * 2; S.c_pn = 512;
          pg8::EpiBf16S E{2048, 1.0f};
          pg8::gemm_phase<pg8::EpiBf16S, pg8::DenseSched, true>(lds, 512, 2048, 512, S, E); }
        __syncthreads();
        {
            lds_t* kimg = lds + 32768; lds_t* vimg = lds + 65536;
            const unsigned keep8 = MISC[8], keep9 = MISC[9];
            __syncthreads();
            const int g = lane >> 4, m15 = lane & 15;
            DECL_AROW(arow); DECL_TRB(trb);
            unsigned rtoff[4];
#pragma unroll
            for (int s = 0; s < 4; ++s) rtoff[s] = off_b((unsigned)m15, 4u * s + (unsigned)g);
            for (int u = bx; u < 1024; u += G) {
                const int b = u >> 8, h = (u >> 6) & 3, c = u & 63; const int row0 = b * SEQ + c * 128;
                const float lg2 = log2f(1.0f - exp2f(-5.0f - (float)h));
                { const char* Rt = (const char*)(rprev + (size_t)u * 32768);
#pragma unroll
                  for (int i = 0; i < 8; ++i) { const int n = wave * 8 + i; const int r = 4 * n + (lane >> 4), ch = (lane & 15) ^ ((((lane >> 4) & 3) << 2) | (n & 3));
                      __builtin_amdgcn_global_load_lds((const unsigned*)(Rt + r * 256 + ch * 16), (LAS unsigned*)((n < 32 ? lds : lds + 131072 - 32768) + n * 1024), 16, 0, 0); } }
                const int il = 16 * wave + m15;
                bf16x8 Qf[4];
                { const bf16* qp = proj + (size_t)(row0 + il) * NPROJ + C_QRET + h * 128 + 8 * g; const float* rp0 = rope + ((size_t)(row0 + il) * 64 + 8 * g) * 2;
#pragma unroll
                  for (int s = 0; s < 2; ++s) { const u32x4 x1 = *(const u32x4*)(qp + 32 * s), x2 = *(const u32x4*)(qp + 32 * s + 64); const f32x4* rp = (const f32x4*)(rp0 + 64 * s);
                      const unsigned xa[4] = {x1.x, x1.y, x1.z, x1.w}, xb[4] = {x2.x, x2.y, x2.z, x2.w}; unsigned o1[4], o2[4];
#pragma unroll
                      for (int p = 0; p < 4; ++p) { const f32x4 cs = rp[p];
                          const float a0 = bflo(xa[p]), a1 = bfhi(xa[p]), b0 = bflo(xb[p]), b1 = bfhi(xb[p]);
                          o1[p] = pk2(a0 * cs.x - b0 * cs.y, a1 * cs.z - b1 * cs.w); o2[p] = pk2(a0 * cs.y + b0 * cs.x, a1 * cs.w + b1 * cs.z); }
                      Qf[s] = __builtin_bit_cast(bf16x8, (u32x4){o1[0], o1[1], o1[2], o1[3]}); Qf[s + 2] = __builtin_bit_cast(bf16x8, (u32x4){o2[0], o2[1], o2[2], o2[3]}); } }
                for (int it = tid; it < 1024; it += NTHREADS) { const int j = (it >> 3) & 127, i0 = (it & 7) * 8;
                    const bf16* kp = proj + (size_t)(row0 + j) * NPROJ + C_KRET + h * 128 + i0;
                    const u32x4 x1 = *(const u32x4*)kp, x2 = *(const u32x4*)(kp + 64);
                    const float sc = 0.08838834764831845f;
                    const f32x4* rp = (const f32x4*)(rope + ((size_t)(row0 + j) * 64 + i0) * 2);
                    const unsigned xa[4] = {x1.x, x1.y, x1.z, x1.w}, xb[4] = {x2.x, x2.y, x2.z, x2.w}; unsigned o1[4], o2[4];
#pragma unroll
                    for (int p = 0; p < 4; ++p) { const f32x4 cs = rp[p];
                        const float a0 = bflo(xa[p]), a1 = bfhi(xa[p]), b0 = bflo(xb[p]), b1 = bfhi(xb[p]);
                        o1[p] = pk2((a0 * cs.x - b0 * cs.y) * sc, (a1 * cs.z - b1 * cs.w) * sc); o2[p] = pk2((a0 * cs.y + b0 * cs.x) * sc, (a1 * cs.w + b1 * cs.z) * sc); }
                    *(LAS u32x4*)(kimg + off_b(j, i0 >> 3)) = (u32x4){o1[0], o1[1], o1[2], o1[3]};
                    *(LAS u32x4*)(kimg + off_b(j, 8 + (i0 >> 3))) = (u32x4){o2[0], o2[1], o2[2], o2[3]}; }
                { const char* vb = (const char*)(proj + (size_t)row0 * NPROJ + C_VRET + h * 256);
#pragma unroll
                  for (int i = 0; i < 8; ++i) { const int n = wave * 8 + i; const int j = 4 * (n & 31) + (lane >> 4), ch = (lane & 15) ^ ((((lane >> 4) & 3) << 2) | (n & 3));
                      __builtin_amdgcn_global_load_lds((const unsigned*)(vb + (size_t)j * (NPROJ * 2) + (n >> 5) * 256 + ch * 16), (LAS unsigned*)(vimg + (n >> 5) * 32768 + (n & 31) * 1024), 16, 0, 0); } }
                asm volatile("s_waitcnt vmcnt(0)" ::: "memory");
                __syncthreads();
                f32x4 oacc[16];
#pragma unroll
                for (int cc = 0; cc < 16; ++cc) oacc[cc] = (f32x4){0.f, 0.f, 0.f, 0.f};
#pragma unroll
                for (int s = 0; s < 4; ++s) { bf16x8 Ar[16];
#pragma unroll
                    for (int cc = 0; cc < 16; ++cc) Ar[cc] = *(const LAS bf16x8*)((cc < 8 ? lds : lds + 131072 - 32768) + 4096 * cc + rtoff[s]);
#pragma unroll
                    for (int cc = 0; cc < 16; ++cc) oacc[cc] = __builtin_amdgcn_mfma_f32_16x16x32_bf16(Ar[cc], Qf[s], oacc[cc], 0, 0, 0);
                    __builtin_amdgcn_sched_barrier(0); }
                const float cdec = exp2f(lg2 * (float)(il + 1));
#pragma unroll
                for (int cc = 0; cc < 16; ++cc) oacc[cc] = oacc[cc] * cdec;
                const bf16* gp = proj + (size_t)(row0 + il) * NPROJ + C_GRET + h * 256 + 4 * g;
                u32x2 gwv[16];
#pragma unroll
                for (int cc = 0; cc < 16; ++cc) gwv[cc] = *(const u32x2*)(gp + 16 * cc);
#pragma unroll 1
                for (int jc = 0; jc <= (wave >> 1); ++jc) {
                    f32x4 sc2[2];
#pragma unroll
                    for (int rb = 0; rb < 2; ++rb) { sc2[rb] = (f32x4){0.f, 0.f, 0.f, 0.f};
#pragma unroll
                        for (int s = 0; s < 4; ++s) { const bf16x8 A = *(const LAS bf16x8*)(kimg + 8192 * jc + arow[rb][s]);
                            sc2[rb] = __builtin_amdgcn_mfma_f32_16x16x32_bf16(A, Qf[s], sc2[rb], 0, 0, 0); } }
                    float p[8];
#pragma unroll
                    for (int rb = 0; rb < 2; ++rb)
#pragma unroll
                        for (int r = 0; r < 4; ++r) { const int j = 32 * jc + 8 * g + 4 * rb + r; const int dd = il - j; p[4 * rb + r] = (dd >= 0) ? sc2[rb][r] * exp2f(lg2 * (float)(dd > 0 ? dd : 0)) : 0.f; }
                    const u32x4 pw = (u32x4){pk2(p[0], p[1]), pk2(p[2], p[3]), pk2(p[4], p[5]), pk2(p[6], p[7])};
                    const bf16x8 Pf = __builtin_bit_cast(bf16x8, pw);
#pragma unroll
                    for (int cc = 0; cc < 16; ++cc) { const lds_t* im = vimg + (cc >> 3) * 32768 + 8192 * jc;
                        const bf16x8 A = cat4(tr_read(im + trb[0][cc & 7]), tr_read(im + trb[1][cc & 7]));
                        oacc[cc] = __builtin_amdgcn_mfma_f32_16x16x32_bf16(A, Pf, oacc[cc], 0, 0, 0); }
                }
                float ss = 0.f;
#pragma unroll
                for (int cc = 0; cc < 16; ++cc) ss += (oacc[cc][0] * oacc[cc][0] + oacc[cc][1] * oacc[cc][1]) + (oacc[cc][2] * oacc[cc][2] + oacc[cc][3] * oacc[cc][3]);
                ss += __shfl_xor(ss, 16); ss += __shfl_xor(ss, 32);
                const float rstd = rsqrtf(ss * (1.f / 256.f) + EPS);
                bf16* op = mix + (size_t)(row0 + il) * 2048 + 1024 + h * 256 + 4 * g;
#pragma unroll
                for (int cc = 0; cc < 16; ++cc) { const u32x2 gw2 = gwv[cc]; const float gv[4] = {bflo(gw2.x), bfhi(gw2.x), bflo(gw2.y), bfhi(gw2.y)}; float o[4];
#pragma unroll
                    for (int r = 0; r < 4; ++r) { const float sg = gv[r] * __builtin_amdgcn_rcpf(1.0f + __builtin_amdgcn_exp2f(-LOG2E * gv[r])); o[r] = sg * oacc[cc][r] * rstd; }
                    *(u32x2*)(op + 16 * cc) = (u32x2){pk2(o[0], o[1]), pk2(o[2], o[3])}; }
                __syncthreads();
            }
            if (tid == 0) { MISC[8] = keep8; MISC[9] = keep9; }
        }
    }
    SEAM(5);

    if (IN(6)) {
        pg8::DenseSched S; S.a_sh = 0; S.r_pm = 0; S.r_pn = 0; S.nM = T / 256; S.nN = 8; S.nwg = S.nM * 8; S.G = G; S.c = bx;
        S.A0 = (const char*)mix; S.B0 = (const char*)w_outT; S.C0 = (char*)hres; S.R0 = (const char*)a.x;
        S.a_pm = 256L * 2048 * 2; S.a_pn = 0; S.b_pn = 256L * 2048 * 2; S.c_pm = 256L * DM * 2; S.c_pn = 512; S.r_pm = 256L * DM * 4; S.r_pn = 1024;
        pg8::EpiResBf16 E{DM, DM, true, nullptr, nullptr, (float*)(ws + WS_SSQ1), (LAS float*)(lds + MOE_TAB_OFF)};
        pg8::gemm_phase<pg8::EpiResBf16, pg8::DenseSched, true>(lds, 2048, 2048, 2048, S, E);
    }
    SEAM(6);


    if (IN(8)) {
        pg8::DenseSched S; S.a_sh = 0; S.r_pm = 0; S.r_pn = 0; S.nM = T / 256; S.nN = 2; S.nwg = S.nM * 2; S.G = G; S.c = bx;
        S.A0 = (const char*)hres; S.B0 = (const char*)w_cqT; S.C0 = (char*)qc; S.R0 = nullptr;
        S.a_pm = 256L * DM * 2; S.a_pn = 0; S.b_pn = 256L * DM * 2; S.c_pm = 256L * 512 * 2; S.c_pn = 512;
        pg8::EpiBf16RS E{512, (const float*)(ws + WS_SSQ1)};
        pg8::gemm_phase<pg8::EpiBf16RS, pg8::DenseSched, true>(lds, DM, DM, DM, S, E);
    }
    SEAM(8);

    if (IN(9)) {
        lds_t* kimg = lds; lds_t* vimg = lds + 65536;
        const int g = lane >> 4, m15 = lane & 15;
        DECL_AROW(arow); DECL_TRB(trb);
        for (int it = bx; it < 256; it += G) {
            const int b = it >> 6, hd = (it >> 4) & 3, slab = it & 15;
            for (int i2 = tid; i2 < 8192; i2 += NTHREADS) { const int which = i2 >> 12, key = (i2 >> 4) & 255, ch = i2 & 15;
                const u32x4 v = *(const u32x4*)(kvc + (size_t)(b * NMEM + key) * 1024 + which * 512 + hd * 128 + ch * 8);
                *(LAS u32x4*)((which ? vimg : kimg) + off_b(key, ch)) = v; }
            __syncthreads();
            bf16x8 Qf[4];
#pragma unroll
            for (int s = 0; s < 4; ++s) Qf[s] = *(const bf16x8*)(qc + (size_t)(b * SEQ + slab * 512 + wave * 16 + m15) * 512 + hd * 128 + 32 * s + 8 * g);
            for (int qt = wave; qt < 32; qt += NWAVES) {
                const int tq = b * SEQ + slab * 512 + qt * 16 + m15;
                f32x4 sc[16];
#pragma unroll
                for (int kb = 0; kb < 16; ++kb) { sc[kb] = (f32x4){0.f, 0.f, 0.f, 0.f};
#pragma unroll
                    for (int s = 0; s < 4; ++s) { const bf16x8 A = *(const LAS bf16x8*)(kimg + 8192 * (kb >> 1) + arow[kb & 1][s]);
                        sc[kb] = __builtin_amdgcn_mfma_f32_16x16x32_bf16(A, Qf[s], sc[kb], 0, 0, 0); }
                    if (kb & 1) __builtin_amdgcn_sched_barrier(0); }
                float mxv = -INFINITY;
                const float scl = 0.08838834764831845f * LOG2E;
#pragma unroll
                for (int kb = 0; kb < 16; ++kb)
#pragma unroll
                    for (int r = 0; r < 4; ++r) { sc[kb][r] *= scl; mxv = fmaxf(mxv, sc[kb][r]); }
                mxv = fmaxf(mxv, __shfl_xor(mxv, 16)); mxv = fmaxf(mxv, __shfl_xor(mxv, 32));
                float ls = 0.f;
#pragma unroll
                for (int kb = 0; kb < 16; ++kb)
#pragma unroll
                    for (int r = 0; r < 4; ++r) { sc[kb][r] = __builtin_amdgcn_exp2f(sc[kb][r] - mxv); ls += sc[kb][r]; }
                ls += __shfl_xor(ls, 16); ls += __shfl_xor(ls, 32);
                f32x4 oacc[8];
#pragma unroll
                for (int cc = 0; cc < 8; ++cc) oacc[cc] = (f32x4){0.f, 0.f, 0.f, 0.f};
#pragma unroll
                for (int kc = 0; kc < 8; ++kc) {
                    const u32x4 pw = (u32x4){pk2(sc[2 * kc][0], sc[2 * kc][1]), pk2(sc[2 * kc][2], sc[2 * kc][3]), pk2(sc[2 * kc + 1][0], sc[2 * kc + 1][1]), pk2(sc[2 * kc + 1][2], sc[2 * kc + 1][3])};
                    const bf16x8 Pf = __builtin_bit_cast(bf16x8, pw);
#pragma unroll
                    for (int cc = 0; cc < 8; ++cc) { const bf16x8 A = cat4(tr_read(vimg + 8192 * kc + trb[0][cc]), tr_read(vimg + 8192 * kc + trb[1][cc]));
                        oacc[cc] = __builtin_amdgcn_mfma_f32_16x16x32_bf16(A, Pf, oacc[cc], 0, 0, 0); }
                    __builtin_amdgcn_sched_barrier(0);
                }
                const float inv = 1.0f / ls;
                { const int qn = (qt + NWAVES < 32) ? qt + NWAVES : qt; const int tn = b * SEQ + slab * 512 + qn * 16 + m15;
#pragma unroll
                  for (int s = 0; s < 4; ++s) Qf[s] = *(const bf16x8*)(qc + (size_t)tn * 512 + hd * 128 + 32 * s + 8 * g); }
                __builtin_amdgcn_sched_barrier(0);
                bf16* op = oc + (size_t)tq * 512 + hd * 128 + 4 * g;
#pragma unroll
                for (int cc = 0; cc < 8; ++cc) { const f32x4 o = oacc[cc] * inv; *(u32x2*)(op + 16 * cc) = (u32x2){pk2(o[0], o[1]), pk2(o[2], o[3])}; }
            }
            __syncthreads();
        }
    }
    SEAM(9);

    if (IN(10)) {
        pg8::DenseSched S; S.a_sh = 0; S.r_pm = 0; S.r_pn = 0; S.nM = T / 256; S.nN = 8; S.nwg = S.nM * 8; S.G = G; S.c = bx;
        S.A0 = (const char*)oc; S.B0 = (const char*)w_coT; S.C0 = (char*)hres; S.R0 = (const char*)hres;
        S.a_pm = 256L * 512 * 2; S.a_pn = 0; S.b_pn = 256L * 512 * 2; S.c_pm = 256L * DM * 2; S.c_pn = 512; S.r_pm = 256L * DM * 2; S.r_pn = 512;
        pg8::EpiResBf16 E{DM, DM, false, asort, a.norm_ffn, (float*)(ws + WS_SSQ2), (LAS float*)(lds + MOE_TAB_OFF)};
        pg8::gemm_phase<pg8::EpiResBf16, pg8::DenseSched, true>(lds, 512, 512, 512, S, E);
    }
    SEAM(10);

    if (IN(11)) {
        LAS float* lt = (LAS float*)(lds + wave * 4608);
        for (int tile = (wave < 4) ? bx * 4 + wave : T / 32; tile < T / 32; tile += G * 4) {
            const int t0 = tile * 32; int l11 = lane; asm volatile("" : "+v"(l11));
            const int i = l11 & 31, kk = l11 >> 5;
            const bf16* hrow = hres + (size_t)(t0 + i) * DM + 4 * kk;
            f32x16 acc = {}; float ssq = 0.f;
            for (int m = 0; m < 256; ++m) {
                const u32x2 hw = *(const u32x2*)(hrow + 8 * m); const f32x4 hv = (f32x4){bflo(hw.x), bfhi(hw.x), bflo(hw.y), bfhi(hw.y)}; const f32x4 gv = *(const f32x4*)(a.norm_ffn + 8 * m + 4 * kk);
                ssq += (hv.x * hv.x + hv.y * hv.y) + (hv.z * hv.z + hv.w * hv.w);
                const float* wp = a.w_router + (size_t)(8 * m + 4 * kk) * NE + i;
                const float b0 = wp[0], b1 = wp[NE], b2 = wp[2 * NE], b3 = wp[3 * NE];
                acc = __builtin_amdgcn_mfma_f32_32x32x2f32(hv.x * gv.x, b0, acc, 0, 0, 0);
                acc = __builtin_amdgcn_mfma_f32_32x32x2f32(hv.y * gv.y, b1, acc, 0, 0, 0);
                acc = __builtin_amdgcn_mfma_f32_32x32x2f32(hv.z * gv.z, b2, acc, 0, 0, 0);
                acc = __builtin_amdgcn_mfma_f32_32x32x2f32(hv.w * gv.w, b3, acc, 0, 0, 0);
            }
            ssq += __shfl_xor(ssq, 32);
            const float rstd = rsqrtf(ssq * (1.f / DM) + EPS);
#pragma unroll
            for (int r = 0; r < 16; ++r) lt[((r & 3) + 8 * (r >> 2) + 4 * kk) * 33 + i] = acc[r];
            LDS_WAIT();
            int e_sel[4]; float v_sel[4];
            {
                float lv[32];
#pragma unroll
                for (int e = 0; e < 32; ++e) lv[e] = lt[i * 33 + e] * rstd + a.b_router[e];
#pragma unroll
                for (int k = 0; k < 4; ++k) { float best = -INFINITY; int be = 0;
#pragma unroll
                    for (int e = 0; e < 32; ++e) { const bool tk = lv[e] > best; best = tk ? lv[e] : best; be = tk ? e : be; }
                    e_sel[k] = be; v_sel[k] = best;
#pragma unroll
                    for (int e = 0; e < 32; ++e) lv[e] = (e == be) ? -INFINITY : lv[e]; }
            }
            LDS_WAIT();
            const float mxl = v_sel[0]; float ex[4], sm = 0.f;
#pragma unroll
            for (int k = 0; k < 4; ++k) { ex[k] = __expf(v_sel[k] - mxl); sm += ex[k]; }
            const float rs = 1.0f / sm;
            const unsigned long long ltmask = (1ull << lane) - 1ull;
#pragma unroll
            for (int k = 0; k < 4; ++k) {
                const int myE = (lane < 32) ? e_sel[k] : -1; int mypos = 0;
                for (int ee = 0; ee < NE; ++ee) { const unsigned long long mk = __ballot(myE == ee);
                    if (mk) { unsigned base = 0; if (lane == 0) base = __hip_atomic_fetch_add(ctl + CW_ECNT + 64 * ee, (unsigned)__builtin_popcountll(mk), __ATOMIC_RELAXED, __HIP_MEMORY_SCOPE_AGENT);
                        base = __builtin_amdgcn_readfirstlane(base); if (myE == ee) mypos = (int)(base + (unsigned)__builtin_popcountll(mk & ltmask)); } }
                if (lane < 32) { tok_e[(t0 + i) * 4 + k] = e_sel[k]; tok_pos[(t0 + i) * 4 + k] = mypos; tok_gate[(t0 + i) * 4 + k] = ex[k] * rs; }
            }
        }
    }
    SEAM(11);

    LAS int* moe_tab = (LAS int*)(lds + MOE_TAB_OFF);
    if (IN(12) || IN(13) || IN(14)) {
        if (tid == 0) { int acc_t = 0; for (int e = 0; e < NE; ++e) { const int cnt = (int)__hip_atomic_load(ctl + CW_ECNT + 64 * e, __ATOMIC_RELAXED, __HIP_MEMORY_SCOPE_AGENT); const int nt = (cnt + 255) >> 8;
                moe_tab[e] = acc_t * 256; for (int j = 0; j < nt; ++j) moe_tab[64 + acc_t + j] = e; acc_t += nt; } moe_tab[32] = acc_t; }
        __syncthreads();
    }
    if (IN(12)) {
        for (int e = gw; e < NE; e += NGW) { const int cnt = (int)__hip_atomic_load(ctl + CW_ECNT + 64 * e, __ATOMIC_RELAXED, __HIP_MEMORY_SCOPE_AGENT);
            const int s0 = moe_tab[e] + cnt, s1 = moe_tab[e] + ((cnt + 255) & ~255); for (int s = s0 + lane; s < s1; s += 64) { slot_tok[s] = 0; slot_rstd[s] = 0.f; } }
        for (int t = bx * NTHREADS + tid; t < T; t += G * NTHREADS) {
            const f32x4 p0 = *(const f32x4*)(ssq2 + (size_t)t * 8), p1 = *(const f32x4*)(ssq2 + (size_t)t * 8 + 4);
            const float rstd = rsqrtf((((p0[0] + p0[1]) + (p0[2] + p0[3])) + ((p1[0] + p1[1]) + (p1[2] + p1[3]))) * (1.f / DM) + EPS);
            const i32x4 te = *(const i32x4*)(tok_e + t * 4), tp = *(const i32x4*)(tok_pos + t * 4); const f32x4 tg = *(const f32x4*)(tok_gate + t * 4);
            i32x4 sl;
#pragma unroll
            for (int k = 0; k < 4; ++k) { const int s = moe_tab[te[k]] + tp[k]; sl[k] = s; slot_tok[s] = t; slot_rstd[s] = rstd; slot_gate[s] = tg[k]; }
            *(i32x4*)(tok_slot + t * 4) = sl;
        }
    }
    SEAM(12);

    if (IN(13)) {
        pg8::MoeSched S; S.NT = 16; S.nunits = __builtin_amdgcn_readfirstlane(moe_tab[32]) * 16; S.G = G; S.c = bx; S.tab = moe_tab + 64;
        S.A0 = (const char*)asort; S.B0 = (const char*)w_gu8; S.C0 = (char*)hmid; S.R0 = (const char*)slot_gate;
        S.rowmap = slot_tok; S.idxb = moe_tab + 1024;
        S.a_mt = 0; S.b_e = (long)2 * DFF * DM; S.b_pn = 256L * DM; S.c_mt = 256L * DFF; S.c_pn = 128; S.r_mt = 1024;
        pg8::EpiSwiglu E{a.b_gu, slot_rstd};
        pg8::gemm_phase<pg8::EpiSwiglu, pg8::MoeSched, true, true, true>(lds, DM / 2, DM / 2, DM / 2, S, E);
    }
    SEAM(13);

    if (IN(14)) {
        pg8::MoeSched S; S.NT = 8; S.nunits = __builtin_amdgcn_readfirstlane(moe_tab[32]) * 8; S.G = G; S.c = bx; S.tab = moe_tab + 64;
        S.A0 = (const char*)hmid; S.B0 = (const char*)w_d8; S.C0 = (char*)ybuf; S.R0 = (const char*)slot_gate;
        S.a_mt = 256L * DFF; S.b_e = (long)DM * DFF; S.b_pn = 256L * DFF; S.c_mt = 256L * DM; S.c_pn = 256; S.r_mt = 1024;
        pg8::EpiDown E{a.b_down};
        pg8::gemm_phase<pg8::EpiDown, pg8::MoeSched, true, true>(lds, DFF / 2, DFF / 2, DFF / 2, S, E);
    }
    SEAM(14);

    if (IN(15)) {
        for (int m = gw; m < T; m += NGW) {
            float* row = a.out + (size_t)m * DM;
            const u32x2* xr = (const u32x2*)(hres + (size_t)m * DM) + lane; const f32x4* gr = (const f32x4*)a.norm_final + lane;
            const int s0 = tok_slot[m * 4 + 0], s1 = tok_slot[m * 4 + 1], s2 = tok_slot[m * 4 + 2], s3 = tok_slot[m * 4 + 3];
            const unsigned char* yb = (const unsigned char*)ybuf;
            const unsigned* y0 = (const unsigned*)(yb + (size_t)s0 * DM) + lane; const unsigned* y1 = (const unsigned*)(yb + (size_t)s1 * DM) + lane;
            const unsigned* y2 = (const unsigned*)(yb + (size_t)s2 * DM) + lane; const unsigned* y3 = (const unsigned*)(yb + (size_t)s3 * DM) + lane;
            f32x4 v[8]; float s = 0.f;
#pragma unroll
            for (int j = 0; j < 8; ++j) { { const u32x2 hw = xr[64 * j]; v[j] = (f32x4){bflo(hw.x), bfhi(hw.x), bflo(hw.y), bfhi(hw.y)}; }
                const unsigned a0 = y0[64 * j], a1 = y1[64 * j], a2 = y2[64 * j], a3 = y3[64 * j];
                const f32x2 l0 = __builtin_amdgcn_cvt_pk_f32_fp8((int)a0, false), h0 = __builtin_amdgcn_cvt_pk_f32_fp8((int)a0, true), l1 = __builtin_amdgcn_cvt_pk_f32_fp8((int)a1, false), h1 = __builtin_amdgcn_cvt_pk_f32_fp8((int)a1, true);
                const f32x2 l2 = __builtin_amdgcn_cvt_pk_f32_fp8((int)a2, false), h2 = __builtin_amdgcn_cvt_pk_f32_fp8((int)a2, true), l3 = __builtin_amdgcn_cvt_pk_f32_fp8((int)a3, false), h3 = __builtin_amdgcn_cvt_pk_f32_fp8((int)a3, true);
                v[j].x += ((l0.x + l1.x) + (l2.x + l3.x)) * (1.0f / Y_S); v[j].y += ((l0.y + l1.y) + (l2.y + l3.y)) * (1.0f / Y_S);
                v[j].z += ((h0.x + h1.x) + (h2.x + h3.x)) * (1.0f / Y_S); v[j].w += ((h0.y + h1.y) + (h2.y + h3.y)) * (1.0f / Y_S);
                s += (v[j].x * v[j].x + v[j].y * v[j].y) + (v[j].z * v[j].z + v[j].w * v[j].w); }
            const float rstd = rsqrtf(wave_sum(s) * (1.f / DM) + EPS);
            f32x4* orow = (f32x4*)row + lane;
#pragma unroll
            for (int j = 0; j < 8; ++j) { const f32x4 g = gr[64 * j]; orow[64 * j] = (f32x4){v[j].x * rstd * g.x, v[j].y * rstd * g.y, v[j].z * rstd * g.z, v[j].w * rstd * g.w}; }
        }
    }
#undef w_inT
#undef w_outT
#undef w_cqT
#undef w_ckvT
#undef w_coT
#undef w_ukb
#undef w_uvP
#undef w_gu8
#undef w_d8
#undef hn
#undef memn
#undef kvc
#undef qc
#undef oc
#undef proj
#undef qlat
#undef sel
#undef nsel
#undef kvbuf
#undef rprev
#undef mix
#undef rope
#undef olat
#undef kfrag
#undef ckv8
#undef hres
#undef asort
#undef hmid
#undef ybuf
#undef tok_e
#undef tok_pos
#undef tok_gate
#undef tok_slot
#undef slot_gate
#undef slot_tok
#undef slot_rstd
#undef ssq2
#undef IN
#undef SEAM
}

constexpr int N_PHASES = 16;
#ifndef MK_ONE_LAUNCH
#define MK_ONE_LAUNCH 1
#endif
#ifndef REP_MASK
#define REP_MASK 0
#endif
extern "C" void kernel_launch(void* const* d_in, const int* in_sizes, int n_in, void* d_out, int out_size, void* d_ws, size_t ws_size, hipStream_t stream) {
    static int grid = 0;
    if (grid == 0) {
        if (n_in != 25 || out_size != T * DM || ws_size < WS_END) { fprintf(stderr, "kernel_launch: unexpected shapes: n_in %d out %d ws %zu (need %zu)\n", n_in, out_size, ws_size, (size_t)WS_END); grid = -1; return; }
        int dev = 0, cus = 0;
        if (hipGetDevice(&dev) != hipSuccess || hipDeviceGetAttribute(&cus, hipDeviceAttributeMultiprocessorCount, dev) != hipSuccess) { grid = -1; return; }
        if (hipFuncSetAttribute((const void*)fwd_kernel, hipFuncAttributeMaxDynamicSharedMemorySize, LDS_BYTES) != hipSuccess) { fprintf(stderr, "kernel_launch: hipFuncSetAttribute failed\n"); grid = -1; return; }
        int per_cu = 0;
        if (hipOccupancyMaxActiveBlocksPerMultiprocessor(&per_cu, (const void*)fwd_kernel, NTHREADS, LDS_BYTES) != hipSuccess || per_cu < 1) { fprintf(stderr, "kernel_launch: occupancy query says %d\n", per_cu); }
        (void)hipGetLastError();
        grid = cus;
    }
    if (grid < 0) return;
    (void)hipMemsetAsync((char*)d_ws + WS_CTL, 0, CTL_ZERO_BYTES, stream);
    Args a{};
    a.x = (const float*)d_in[0]; a.mem = (const float*)d_in[1]; a.positions = (const int*)d_in[2]; a.norm_mix = (const float*)d_in[3]; a.w_in = (const float*)d_in[4];
    a.kv_norm = (const float*)d_in[5]; a.idx_k_norm = (const float*)d_in[6]; a.w_uk = (const float*)d_in[7]; a.w_uv = (const float*)d_in[8]; a.rel_bias = (const float*)d_in[9];
    a.w_out = (const float*)d_in[10]; a.norm_cross = (const float*)d_in[11]; a.norm_mem = (const float*)d_in[12]; a.w_cq = (const float*)d_in[13]; a.w_ck = (const float*)d_in[14];
    a.w_cv = (const float*)d_in[15]; a.w_co = (const float*)d_in[16]; a.norm_ffn = (const float*)d_in[17]; a.w_router = (const float*)d_in[18]; a.b_router = (const float*)d_in[19];
    a.w_gu = (const float*)d_in[20]; a.b_gu = (const float*)d_in[21]; a.w_down = (const float*)d_in[22]; a.b_down = (const float*)d_in[23]; a.norm_final = (const float*)d_in[24];
    a.out = (float*)d_out; a.ws = (unsigned char*)d_ws; a.pad = 0;
#if MK_ONE_LAUNCH
    a.ph_lo = 0; a.ph_hi = N_PHASES; a.use_bar = 1;
    hipLaunchKernelGGL(fwd_kernel, dim3(grid), dim3(NTHREADS), LDS_BYTES, stream, a);
#else
    for (int p = 0; p < N_PHASES; ++p) { a.ph_lo = p; a.ph_hi = p + 1; a.use_bar = 0; const int reps = ((REP_MASK >> p) & 1) ? 2 : 1;
        for (int r = 0; r < reps; ++r) hipLaunchKernelGGL(fwd_kernel, dim3(grid), dim3(NTHREADS), LDS_BYTES, stream, a); }
#endif
}
```

```cpp
#include <hip/hip_runtime.h>
#include <cstdio>
#include <cstdint>
#include <cmath>

#define LAS __attribute__((address_space(3)))
#define GAS __attribute__((address_space(1)))
typedef unsigned short bf16;
typedef short bf16x8 __attribute__((ext_vector_type(8)));
typedef short s16x4 __attribute__((ext_vector_type(4)));
typedef float f32x4 __attribute__((ext_vector_type(4)));
typedef float f32x2 __attribute__((ext_vector_type(2)));
typedef float f32x16 __attribute__((ext_vector_type(16)));
typedef unsigned u32x4 __attribute__((ext_vector_type(4)));
typedef int i32x4 __attribute__((ext_vector_type(4)));
typedef unsigned u32x2 __attribute__((ext_vector_type(2)));
typedef LAS unsigned char lds_t;

constexpr int BATCH = 4, SEQ = 8192, T = BATCH * SEQ, DM = 2048;
constexpr int NPROJ = 5632;
constexpr int C_QATT = 0, C_CKV = 1024, C_QIDX = 1280, C_KIDX = 2304, C_WIDX = 2368, C_QRET = 2560, C_KRET = 3072, C_VRET = 3584, C_GRET = 4608;
constexpr int IN_WIDTH = 5456;
constexpr int NE = 32, TOPK = 4, DFF = 2048;
constexpr int SLOTS = T * TOPK + NE * 256;
constexpr int NMEM = 256;
constexpr float EPS = 1e-6f;
constexpr float LOG2E = 1.4426950408889634f;

constexpr size_t MiB = 1u << 20;
constexpr size_t WS_CTL = 0, CTL_ZERO_BYTES = 1 * MiB;
constexpr size_t WS_WIN_T = 1 * MiB, WS_WOUT_T = 23 * MiB, WS_WCQ_T = 31 * MiB, WS_WCKV_T = 33 * MiB, WS_WCO_T = 37 * MiB, WS_WUK = 39 * MiB, WS_WUVP = 40 * MiB;
constexpr size_t WS_WGU_T = 41 * MiB, WS_WD_T = 553 * MiB;
constexpr size_t WS_HN = 809 * MiB, WS_MEMN = 937 * MiB, WS_KVC = 941 * MiB, WS_QC = 943 * MiB, WS_OC = 975 * MiB, WS_ROUTE = 1007 * MiB;
constexpr size_t WS_X = 1011 * MiB;
constexpr size_t X_PROJ = WS_X, X_QLAT = WS_X + 352 * MiB, X_SEL = WS_X + 480 * MiB, X_NSEL = WS_X + 512 * MiB, X_KV = WS_X + 513 * MiB, X_RPREV = WS_X + 641 * MiB, X_MIX = WS_X + 705 * MiB, X_ROPE = WS_X + 833 * MiB, X_OLAT = WS_X + 849 * MiB, X_KFRAG = WS_X + 977 * MiB, X_CKV8 = WS_X + 981 * MiB;
constexpr size_t X_ASORT = WS_X, X_HMID = WS_X + 272 * MiB, X_Y = WS_X + 544 * MiB;
constexpr size_t WS_HRES = WS_X + 1088 * MiB;
constexpr size_t WS_END = WS_HRES + 128 * MiB;
constexpr size_t R_TOKE = WS_ROUTE, R_TOKPOS = WS_ROUTE + MiB / 2, R_TOKGATE = WS_ROUTE + MiB, R_TOKSLOT = WS_ROUTE + 3 * MiB / 2, R_SLOTGATE = WS_ROUTE + 2 * MiB, R_SLOTTOK = WS_ROUTE + 3 * MiB;
constexpr size_t WS_SSQ1 = WS_HN, WS_SSQ2 = WS_HN + 2 * MiB, WS_SLOTRSTD = WS_HN + 4 * MiB;
constexpr int CW_TMO = 0, CW_BAR = 4096, CW_ECNT = 16384;

constexpr int IDX_NB = 2;
constexpr int LDS_BYTES = 163840;
constexpr int MISC_OFF = LDS_BYTES - 256;
constexpr int MOE_TAB_OFF = 131072;

constexpr int NWAVES = 8, NTHREADS = 512;

__device__ __forceinline__ unsigned f2bf(float f) { unsigned u = __float_as_uint(f); return (u + 0x7fffu + ((u >> 16) & 1u)) >> 16; }
__device__ __forceinline__ unsigned pk2(float lo, float hi) { typedef __bf16 bf16x2_t_ __attribute__((ext_vector_type(2))); return __builtin_bit_cast(unsigned, __builtin_convertvector((f32x2){lo, hi}, bf16x2_t_)); }
__device__ __forceinline__ float bflo(unsigned w) { return __uint_as_float(w << 16); }
__device__ __forceinline__ float bfhi(unsigned w) { return __uint_as_float(w & 0xffff0000u); }
__device__ __forceinline__ float bf2f(bf16 v) { return __uint_as_float((unsigned)v << 16); }
__device__ __forceinline__ unsigned pk4_fp8(float a, float b, float c, float d) {
    a = __builtin_amdgcn_fmed3f(a, -448.f, 448.f); b = __builtin_amdgcn_fmed3f(b, -448.f, 448.f); c = __builtin_amdgcn_fmed3f(c, -448.f, 448.f); d = __builtin_amdgcn_fmed3f(d, -448.f, 448.f);
    int r = __builtin_amdgcn_cvt_pk_fp8_f32(a, b, 0, false); r = __builtin_amdgcn_cvt_pk_fp8_f32(c, d, r, true); return (unsigned)r; }
__device__ __forceinline__ unsigned pk4_fp8_nc(float a, float b, float c, float d) {
    int r = __builtin_amdgcn_cvt_pk_fp8_f32(a, b, 0, false); r = __builtin_amdgcn_cvt_pk_fp8_f32(c, d, r, true); return (unsigned)r; }
constexpr float Y_S = 16.0f;
constexpr float IDX_QS = 16.0f, IDX_KS = 16.0f;
constexpr float CKV_S = 16.0f;
constexpr float FP8_RS = 8.0f;
constexpr float FP8_XS = 8.0f, FP8_WS = 32.0f, FP8_HS = 4.0f;
#define LDS_WAIT() asm volatile("s_waitcnt lgkmcnt(0)" ::: "memory")
#define VM_WAIT() asm volatile("s_waitcnt vmcnt(0)" ::: "memory")
__device__ __forceinline__ float wave_sum(float v) {
#pragma unroll
    for (int o = 1; o < 64; o <<= 1) v += __shfl_xor(v, o);
    return v;
}
__device__ __forceinline__ s16x4 tr_read(const lds_t* p) {
    typedef short v4i16_t __attribute__((ext_vector_type(4)));
    return __builtin_bit_cast(s16x4, __builtin_amdgcn_ds_read_tr16_b64_v4i16((LAS v4i16_t*)p));
}
__device__ __forceinline__ bf16x8 cat4(s16x4 a, s16x4 b) { bf16x8 r; r[0] = a[0]; r[1] = a[1]; r[2] = a[2]; r[3] = a[3]; r[4] = b[0]; r[5] = b[1]; r[6] = b[2]; r[7] = b[3]; return r; }
__device__ __forceinline__ unsigned off_b(unsigned row, unsigned ch) { return 256u * row + 16u * (ch ^ (((row & 3u) << 2) | ((row >> 2) & 3u))); }
__device__ __forceinline__ unsigned tr_addr16(unsigned lane, unsigned row0, unsigned c, unsigned t) {
    const unsigned g = lane >> 4, q = (lane & 15u) >> 2, p = lane & 3u;
    return off_b(row0 + 8u * g + 4u * t + q, 2u * c + (p >> 1)) + 8u * (p & 1u);
}

#define DECL_AROW(arow) unsigned arow[2][4]; _Pragma("unroll") for (int rb_ = 0; rb_ < 2; ++rb_) _Pragma("unroll") for (int s_ = 0; s_ < 4; ++s_) \
    arow[rb_][s_] = off_b(8u * ((lane & 15) >> 2) + 4u * rb_ + (lane & 3), 4u * s_ + (lane >> 4))
#define DECL_TRB(trb) unsigned trb[2][8]; _Pragma("unroll") for (int t_ = 0; t_ < 2; ++t_) _Pragma("unroll") for (int c_ = 0; c_ < 8; ++c_) trb[t_][c_] = tr_addr16(lane, 0, c_, t_)

namespace pg8 {
constexpr int BM = 256, BK = 64, HALF = 128, HTB = HALF * BK * 2, STAGE_BYTES = 8 * HTB;
__host__ __device__ __forceinline__ int lds_byte(int r, int c) { const int st = (r >> 4) * 2 + (c >> 5), rr = r & 15, cc = c & 31, ob = rr * 64 + cc * 2; return st * 1024 + (ob ^ (((ob >> 9) & 1) << 5)); }
__host__ __device__ __forceinline__ void stage_rc(int b, int& R, int& C) { const int st = b / 1024, sb = b % 1024, swz = sb ^ (((sb >> 9) & 1) << 5); R = (st >> 1) * 16 + swz / 64; C = (st & 1) * 32 + (swz % 64) / 2; }
__host__ __device__ __forceinline__ int perm32(int rho) { const int n = rho >> 4, i = rho & 15; return 8 * (i >> 2) + 4 * n + (i & 3); }

struct Unit { const char* A; const char* B; char* C; const char* R; int e; int pn; int m0; };

struct DenseSched {
    int nM, nN, nwg, G, c;
    const char* A0; const char* B0; char* C0; const char* R0;
    long a_pm, a_pn, b_pn, c_pm, c_pn, r_pm, r_pn; int a_sh;
    __device__ __forceinline__ bool next(int i, Unit& u) const {
        const long L = (long)i * G + c; if (L >= nwg) return false;
        int wgid = (int)L; { const int q = nwg / 8, r = nwg % 8, xcd = wgid % 8, off = wgid / 8; wgid = (xcd < r ? xcd * (q + 1) : r * (q + 1) + (xcd - r) * q) + off; }
        const int nig = 8 * nN, gid = wgid / nig, fm = gid * 8, gsz = (nM - fm) < 8 ? (nM - fm) : 8;
        const int pm = fm + ((wgid % nig) % gsz), pn = (wgid % nig) / gsz;
        u.A = A0 + pm * a_pm + (pn >> a_sh) * a_pn; u.B = B0 + pn * b_pn; u.C = C0 + pm * c_pm + pn * c_pn; u.R = R0 ? R0 + pm * r_pm + pn * r_pn : nullptr; u.e = pm; u.pn = pn; u.m0 = 0; return true;
    }
};
struct MoeSched {
    int NT, nunits, G, c;
    const LAS int* tab;
    const int* rowmap = nullptr; LAS int* idxb = nullptr;
    const char* A0; const char* B0; char* C0; const char* R0;
    long a_mt, b_e, b_pn, c_mt, c_pn, r_mt;
    __device__ __forceinline__ bool next(int i, Unit& u) const {
        const long L = (long)i * G + c; if (L >= nunits) return false;
        const int mt = (int)(L / NT), pn = (int)(L % NT);
        const int e = __builtin_amdgcn_readfirstlane(tab[mt]);
        u.A = A0 + mt * a_mt; u.B = B0 + e * b_e + pn * b_pn; u.C = C0 + mt * c_mt + pn * c_pn; u.R = R0 + mt * r_mt; u.e = e; u.pn = pn; u.m0 = mt * 256; return true;
    }
};

__device__ __forceinline__ unsigned cvt_pk_bf16(float lo, float hi) { unsigned r; asm volatile("v_cvt_pk_bf16_f32 %0, %1, %2" : "=v"(r) : "v"(lo), "v"(hi)); return r; }

struct EpiBf16S {
    static constexpr bool PERM = true;
    int ldc; float scale;
    __device__ __forceinline__ void operator()(const f32x4 (&acc)[2][2][4][2], const Unit& u, int wr, int wc, int fr, int fq) const {
        asm volatile("" : "+v"(fr), "+v"(fq));
        bf16* C = (bf16*)u.C; const int row0 = wr * 64 + fr, col0 = wc * 32 + 8 * fq;
#pragma unroll
        for (int ai = 0; ai < 2; ++ai)
#pragma unroll
            for (int m = 0; m < 4; ++m) { bf16* rowp = C + (size_t)(row0 + ai * HALF + m * 16) * ldc + col0;
#pragma unroll
                for (int bj = 0; bj < 2; ++bj) { const f32x4 v0 = acc[ai][bj][m][0] * scale, v1 = acc[ai][bj][m][1] * scale;
                    u32x4 w; w.x = cvt_pk_bf16(v0[0], v0[1]); w.y = cvt_pk_bf16(v0[2], v0[3]); w.z = cvt_pk_bf16(v1[0], v1[1]); w.w = cvt_pk_bf16(v1[2], v1[3]);
                    *(u32x4*)(rowp + bj * HALF) = w; } }
    }
};
struct EpiBf16RS {
    static constexpr bool PERM = true;
    int ldc; const float* ssq;
    __device__ __forceinline__ void operator()(const f32x4 (&acc)[2][2][4][2], const Unit& u, int wr, int wc, int fr, int fq) const {
        asm volatile("" : "+v"(fr), "+v"(fq));
        bf16* C = (bf16*)u.C; const int row0 = wr * 64 + fr, col0 = wc * 32 + 8 * fq;
        const float* sp = ssq + ((size_t)u.e * 256 + row0) * 8;
        f32x4 pa[8][2];
#pragma unroll
        for (int g = 0; g < 8; ++g) { const float* p = sp + (size_t)((g >> 2) * HALF + (g & 3) * 16) * 8; pa[g][0] = *(const f32x4*)p; pa[g][1] = *(const f32x4*)(p + 4); }
#pragma unroll
        for (int g = 0; g < 8; ++g) { const float s = ((pa[g][0][0] + pa[g][0][1]) + (pa[g][0][2] + pa[g][0][3])) + ((pa[g][1][0] + pa[g][1][1]) + (pa[g][1][2] + pa[g][1][3]));
            const float rstd = rsqrtf(s * (1.0f / DM) + EPS);
            bf16* rowp = C + (size_t)(row0 + (g >> 2) * HALF + (g & 3) * 16) * ldc + col0;
#pragma unroll
            for (int bj = 0; bj < 2; ++bj) { const f32x4 v0 = acc[g >> 2][bj][g & 3][0] * rstd, v1 = acc[g >> 2][bj][g & 3][1] * rstd;
                u32x4 w; w.x = cvt_pk_bf16(v0[0], v0[1]); w.y = cvt_pk_bf16(v0[2], v0[3]); w.z = cvt_pk_bf16(v1[0], v1[1]); w.w = cvt_pk_bf16(v1[2], v1[3]);
                *(u32x4*)(rowp + bj * HALF) = w; } }
    }
};
struct EpiResF32 {
    static constexpr bool PERM = false;
    int ldc;
    __device__ __forceinline__ void operator()(const f32x4 (&acc)[2][2][4][2], const Unit& u, int wr, int wc, int fr, int fq) const {
        asm volatile("" : "+v"(fr), "+v"(fq));
        float* C = (float*)u.C; const float* R = (const float*)u.R; const int row0 = wr * 64 + fr, col0 = wc * 32 + 4 * fq;
#pragma unroll
        for (int ai = 0; ai < 2; ++ai)
#pragma unroll
            for (int m = 0; m < 4; ++m) { const size_t ro = (size_t)(row0 + ai * HALF + m * 16) * ldc + col0;
#pragma unroll
                for (int bj = 0; bj < 2; ++bj)
#pragma unroll
                    for (int n = 0; n < 2; ++n) { const size_t o = ro + bj * HALF + n * 16; *(f32x4*)(C + o) = *(const f32x4*)(R + o) + acc[ai][bj][m][n]; } }
    }
};
struct EpiResBf16 {
    static constexpr bool PERM = true;
    int ldc, ldr; bool rf32;
    unsigned char* h8 = nullptr; const float* gain = nullptr;
    float* ssq = nullptr; LAS float* part = nullptr;
    __device__ __forceinline__ void operator()(const f32x4 (&acc)[2][2][4][2], const Unit& u, int wr, int wc, int fr, int fq) const {
        asm volatile("" : "+v"(fr), "+v"(fq));
        bf16* C = (bf16*)u.C; const int row0 = wr * 64 + fr, col0 = wc * 32 + 8 * fq;
        if (rf32) {
            const float* R = (const float*)u.R + (size_t)row0 * ldr + col0;
            f32x4 rb[8][2][2]; u32x4 w0[2], w1[2];
#define ERB_LOAD(g) do { _Pragma("unroll") for (int bj = 0; bj < 2; ++bj) { const float* rp = R + (size_t)(((g) >> 2) * HALF + ((g) & 3) * 16) * ldr + bj * HALF; rb[g][bj][0] = *(const f32x4*)rp; rb[g][bj][1] = *(const f32x4*)(rp + 4); } } while (0)
#define ERB_PACK(g, WV) do { float sq_ = 0.f; _Pragma("unroll") for (int bj = 0; bj < 2; ++bj) { const f32x4 v0 = acc[(g) >> 2][bj][(g) & 3][0] + rb[g][bj][0], v1 = acc[(g) >> 2][bj][(g) & 3][1] + rb[g][bj][1]; \
                sq_ += ((v0[0] * v0[0] + v0[1] * v0[1]) + (v0[2] * v0[2] + v0[3] * v0[3])) + ((v1[0] * v1[0] + v1[1] * v1[1]) + (v1[2] * v1[2] + v1[3] * v1[3])); \
                WV[bj].x = cvt_pk_bf16(v0[0], v0[1]); WV[bj].y = cvt_pk_bf16(v0[2], v0[3]); WV[bj].z = cvt_pk_bf16(v1[0], v1[1]); WV[bj].w = cvt_pk_bf16(v1[2], v1[3]); } \
                if (ssq) { sq_ += __shfl_xor(sq_, 16); sq_ += __shfl_xor(sq_, 32); if (fq == 0) part[(wr * 64 + fr + ((g) >> 2) * HALF + ((g) & 3) * 16) * 4 + wc] = sq_; } } while (0)
#define ERB_STORE(g, WV) do { bf16* rowp = C + (size_t)(row0 + ((g) >> 2) * HALF + ((g) & 3) * 16) * ldc + col0; *(u32x4*)rowp = WV[0]; *(u32x4*)(rowp + HALF) = WV[1]; } while (0)
            ERB_LOAD(0); ERB_LOAD(1); ERB_LOAD(2); ERB_LOAD(3); ERB_LOAD(4);
            __builtin_amdgcn_sched_barrier(0);
            ERB_PACK(0, w0); ERB_PACK(1, w1);
            __builtin_amdgcn_sched_barrier(0);
            ERB_LOAD(5); ERB_LOAD(6);
            __builtin_amdgcn_sched_barrier(0);
            ERB_STORE(0, w0); ERB_STORE(1, w1);
            ERB_PACK(2, w0);
            __builtin_amdgcn_sched_barrier(0);
            ERB_LOAD(7);
            __builtin_amdgcn_sched_barrier(0);
            ERB_STORE(2, w0);
#pragma unroll
            for (int g = 3; g < 8; ++g) { ERB_PACK(g, w0); ERB_STORE(g, w0); }
            if (ssq) {
                asm volatile("s_waitcnt lgkmcnt(0)" ::: "memory"); __builtin_amdgcn_s_barrier();
                const int t_ = threadIdx.x;
                if (t_ < 256) { const f32x4 p = *(const LAS f32x4*)(part + t_ * 4); ssq[((size_t)u.e * 256 + t_) * 8 + u.pn] = (p[0] + p[1]) + (p[2] + p[3]); }
            }
#undef ERB_LOAD
#undef ERB_PACK
#undef ERB_STORE
        } else {
            const bf16* R = (const bf16*)u.R + (size_t)row0 * ldr + col0;
            u32x4 rw[8][2], oA[2], oB[2]; u32x2 hA[2], hB[2];
#define ERC_LOAD(g) do { _Pragma("unroll") for (int bj = 0; bj < 2; ++bj) rw[g][bj] = *(const u32x4*)(R + (size_t)(((g) >> 2) * HALF + ((g) & 3) * 16) * ldr + bj * HALF); } while (0)
#define ERC_PACK(g, OV, HV) do { float sq_ = 0.f; _Pragma("unroll") for (int bj = 0; bj < 2; ++bj) { const u32x4 w = rw[g][bj]; \
                const f32x4 r0 = (f32x4){bflo(w.x), bfhi(w.x), bflo(w.y), bfhi(w.y)}, r1 = (f32x4){bflo(w.z), bfhi(w.z), bflo(w.w), bfhi(w.w)}; \
                const f32x4 v0 = acc[(g) >> 2][bj][(g) & 3][0] + r0, v1 = acc[(g) >> 2][bj][(g) & 3][1] + r1; \
                OV[bj].x = cvt_pk_bf16(v0[0], v0[1]); OV[bj].y = cvt_pk_bf16(v0[2], v0[3]); OV[bj].z = cvt_pk_bf16(v1[0], v1[1]); OV[bj].w = cvt_pk_bf16(v1[2], v1[3]); \
                if (h8) { sq_ += ((v0[0] * v0[0] + v0[1] * v0[1]) + (v0[2] * v0[2] + v0[3] * v0[3])) + ((v1[0] * v1[0] + v1[1] * v1[1]) + (v1[2] * v1[2] + v1[3] * v1[3])); \
                    const f32x4 q0 = v0 * gq[bj][0], q1 = v1 * gq[bj][1]; HV[bj] = (u32x2){pk4_fp8(q0[0], q0[1], q0[2], q0[3]), pk4_fp8(q1[0], q1[1], q1[2], q1[3])}; } } \
            if (h8) { sq_ += __shfl_xor(sq_, 16); sq_ += __shfl_xor(sq_, 32); if (fq == 0) part[(row0 + ((g) >> 2) * HALF + ((g) & 3) * 16) * 4 + wc] = sq_; } } while (0)
#define ERC_STORE(g, OV, HV) do { const int row = row0 + ((g) >> 2) * HALF + ((g) & 3) * 16; bf16* rowp = C + (size_t)row * ldc + col0; *(u32x4*)rowp = OV[0]; *(u32x4*)(rowp + HALF) = OV[1]; \
            if (h8) { unsigned char* hp = h8 + ((size_t)u.e * 256 + row) * DM + u.pn * 256 + col0; *(u32x2*)hp = HV[0]; *(u32x2*)(hp + HALF) = HV[1]; } } while (0)
            ERC_LOAD(0); ERC_LOAD(1); ERC_LOAD(2); ERC_LOAD(3); ERC_LOAD(4); ERC_LOAD(5);
            f32x4 gq[2][2];
            if (h8) {
#pragma unroll
                for (int bj = 0; bj < 2; ++bj) { const float* gp = gain + u.pn * 256 + col0 + bj * HALF; gq[bj][0] = *(const f32x4*)gp * FP8_RS; gq[bj][1] = *(const f32x4*)(gp + 4) * FP8_RS; }
            }
            __builtin_amdgcn_sched_barrier(0);
            ERC_PACK(0, oA, hA); ERC_PACK(1, oB, hB);
            __builtin_amdgcn_sched_barrier(0);
            ERC_LOAD(6); ERC_LOAD(7);
            __builtin_amdgcn_sched_barrier(0);
            ERC_STORE(0, oA, hA); ERC_STORE(1, oB, hB);
#pragma unroll
            for (int g = 2; g < 8; ++g) { ERC_PACK(g, oA, hA); ERC_STORE(g, oA, hA); }
#undef ERC_LOAD
#undef ERC_PACK
#undef ERC_STORE
            if (h8) {
                asm volatile("s_waitcnt lgkmcnt(0)" ::: "memory"); __builtin_amdgcn_s_barrier();
                const int t_ = threadIdx.x;
                if (t_ < 256) { const f32x4 p = *(const LAS f32x4*)(part + t_ * 4); ssq[((size_t)u.e * 256 + t_) * 8 + u.pn] = (p[0] + p[1]) + (p[2] + p[3]); }
            }
        }
    }
};
struct EpiSwiglu {
    static constexpr bool PERM = true;
    const float* b_gu;
    const float* row_rstd;
    __device__ __forceinline__ void operator()(const f32x4 (&acc)[2][2][4][2], const Unit& u, int wr, int wc, int fr, int fq) const {
        asm volatile("" : "+v"(fr), "+v"(fq));
        const int row0 = wr * 64 + fr, colw = wc * 32 + 8 * fq;
        const float* bp = b_gu + (size_t)u.e * (2 * DFF) + u.pn * 128 + colw;
        constexpr float CS = 1.0f / (FP8_RS * FP8_WS), KE = -1.702f * LOG2E, CK = CS * KE, XMIN = 7.0f * KE, UPS = FP8_HS / KE;
        f32x4 bgk[2], bu[2]; float rs[8];
#pragma unroll
        for (int n = 0; n < 2; ++n) { bgk[n] = *(const f32x4*)(bp + 4 * n) * KE; bu[n] = *(const f32x4*)(bp + DFF + 4 * n); }
#pragma unroll
        for (int g = 0; g < 8; ++g) rs[g] = row_rstd[u.m0 + row0 + (g >> 2) * HALF + (g & 3) * 16];
#pragma unroll
        for (int ai = 0; ai < 2; ++ai)
#pragma unroll
            for (int m = 0; m < 4; ++m) { unsigned char* rowp = (unsigned char*)u.C + (size_t)(row0 + ai * HALF + m * 16) * DFF + colw;
                f32x4 h[2];
                const float ck = rs[ai * 4 + m] * CK, cs = rs[ai * 4 + m] * CS;
#pragma unroll
                for (int n = 0; n < 2; ++n) { f32x4 x = acc[ai][0][m][n] * ck + bgk[n], uu = acc[ai][1][m][n] * cs + bu[n], r;
#pragma unroll
                    for (int j = 0; j < 4; ++j) { x[j] = fmaxf(x[j], XMIN); uu[j] = fminf(fmaxf(uu[j], -7.0f), 7.0f); }
#pragma unroll
                    for (int j = 0; j < 4; ++j) r[j] = __builtin_amdgcn_exp2f(x[j]);
                    r = r + 1.0f;
#pragma unroll
                    for (int j = 0; j < 4; ++j) r[j] = __builtin_amdgcn_rcpf(r[j]);
                    h[n] = (uu * UPS + UPS) * (x * r); }
                *(u32x2*)rowp = (u32x2){pk4_fp8_nc(h[0][0], h[0][1], h[0][2], h[0][3]), pk4_fp8_nc(h[1][0], h[1][1], h[1][2], h[1][3])}; }
    }
};
struct EpiDown {
    static constexpr bool PERM = true;
    const float* b_down;
    __device__ __forceinline__ void operator()(const f32x4 (&acc)[2][2][4][2], const Unit& u, int wr, int wc, int fr, int fq) const {
        asm volatile("" : "+v"(fr), "+v"(fq));
        const float* gate = (const float*)u.R; const int row0 = wr * 64 + fr, colw = wc * 32 + 8 * fq;
        const float* bp = b_down + (size_t)u.e * DM + u.pn * 256 + colw;
        f32x4 bd[2][2];
#pragma unroll
        for (int bj = 0; bj < 2; ++bj)
#pragma unroll
            for (int n = 0; n < 2; ++n) bd[bj][n] = *(const f32x4*)(bp + bj * HALF + 4 * n);
        float gts[8];
#pragma unroll
        for (int g = 0; g < 8; ++g) gts[g] = gate[row0 + (g >> 2) * HALF + (g & 3) * 16];
        __builtin_amdgcn_sched_barrier(0);
#pragma unroll
        for (int ai = 0; ai < 2; ++ai)
#pragma unroll
            for (int m = 0; m < 4; ++m) { const int row = row0 + ai * HALF + m * 16; const float gt = gts[ai * 4 + m] * Y_S; unsigned char* rowp = (unsigned char*)u.C + (size_t)row * DM + colw;
#pragma unroll
                for (int bj = 0; bj < 2; ++bj) { const f32x4 v0 = (acc[ai][bj][m][0] * (1.0f / (FP8_HS * FP8_WS)) + bd[bj][0]) * gt, v1 = (acc[ai][bj][m][1] * (1.0f / (FP8_HS * FP8_WS)) + bd[bj][1]) * gt;
                    *(u32x2*)(rowp + bj * HALF) = (u32x2){pk4_fp8(v0[0], v0[1], v0[2], v0[3]), pk4_fp8(v1[0], v1[1], v1[2], v1[3])}; } }
    }
};

template <class Epi, class Sched, bool ALIGN_EPI, bool FP8 = false, bool GATHER = false>
__device__ __forceinline__ void gemm_phase(lds_t* lds, const int K, const int lda, const int ldb, const Sched& S, const Epi& E) {
    const int tid = threadIdx.x, wid = __builtin_amdgcn_readfirstlane(tid >> 6), lane = tid & 63, wr = wid >> 2, wc = wid & 3, fr = lane & 15, fq = lane >> 4;
    const int nt = K / BK;
    unsigned voffA[2], voffB[2];
#pragma unroll
    for (int i = 0; i < 2; ++i) { int R, C; stage_rc(tid * 16 + i * 8192, R, C); const int Rb = Epi::PERM ? ((R & ~31) + perm32(R & 31)) : R;
        voffA[i] = (unsigned)(R * lda + C) * 2u; voffB[i] = (unsigned)(Rb * ldb + C) * 2u; }
    const size_t kstep = (size_t)(BK * 2);
    const size_t hstepA = GATHER ? (size_t)0 : (size_t)HALF * lda * 2, hstepB = (size_t)HALF * ldb * 2;
    const unsigned ldsw = (unsigned)wid * 1024u;
    const int aoff = lds_byte(wr * 64 + fr, fq * 8), boff = lds_byte(wc * 32 + fr, fq * 8);
    unsigned voffA1[2] = {0u, 0u};
#define PG8_GOFF(dst0, dst1, ibase) do { _Pragma("unroll") for (int _i = 0; _i < 2; ++_i) { int R_, C_; stage_rc(tid * 16 + _i * 8192, R_, C_); \
        dst0[_i] = (unsigned)(ibase)[R_] * (unsigned)(lda * 2) + (unsigned)C_ * 2u; dst1[_i] = (unsigned)(ibase)[R_ + HALF] * (unsigned)(lda * 2) + (unsigned)C_ * 2u; } } while (0)
#define PG8_SA(b, h) (((b) * 2 + (h)) * HTB)
#define PG8_SB(b, h) ((4 + (b) * 2 + (h)) * HTB)
#define PG8_STAGE(bufoff, gbase, voff) do { _Pragma("unroll") for (int _i = 0; _i < 2; ++_i) \
        __builtin_amdgcn_global_load_lds((const unsigned*)((const char*)(gbase) + (voff)[_i]), (LAS unsigned*)(lds + (bufoff) + ldsw + _i * 8192), 16, 0, 0); } while (0)
#define PG8_LD8(off_) __builtin_shufflevector(*(const LAS v4i_t*)(lds + (off_)), *(const LAS v4i_t*)(lds + (off_) + 1024), 0, 1, 2, 3, 4, 5, 6, 7)
#define PG8_LDA(dst, b, h) do { if constexpr (FP8) { _Pragma("unroll") for (int m = 0; m < 4; ++m) dst##8[m] = PG8_LD8(PG8_SA(b, h) + aoff + m * 2048); } \
        else { _Pragma("unroll") for (int m = 0; m < 4; ++m) _Pragma("unroll") for (int k = 0; k < 2; ++k) dst[m][k] = *(const LAS bf16x8*)(lds + PG8_SA(b, h) + aoff + m * 2048 + k * 1024); } } while (0)
#define PG8_LDB(dst, b, h) do { if constexpr (FP8) { _Pragma("unroll") for (int n = 0; n < 2; ++n) dst##8[n] = PG8_LD8(PG8_SB(b, h) + boff + n * 2048); } \
        else { _Pragma("unroll") for (int n = 0; n < 2; ++n) _Pragma("unroll") for (int k = 0; k < 2; ++k) dst[n][k] = *(const LAS bf16x8*)(lds + PG8_SB(b, h) + boff + n * 2048 + k * 1024); } } while (0)
#define PG8_MMA(ai, bj, At, Bt) do { __builtin_amdgcn_s_setprio(1); _Pragma("unroll") for (int m = 0; m < 4; ++m) _Pragma("unroll") for (int n = 0; n < 2; ++n) { \
        if constexpr (FP8) asm volatile("v_mfma_scale_f32_16x16x128_f8f6f4 %0, %1, %2, %0, %3, %3 op_sel_hi:[0,0,0]" : "+v"(acc[ai][bj][m][n]) : "v"(Bt##8[n]), "v"(At##8[m]), "v"(one_scale));   \
        else { _Pragma("unroll") for (int k = 0; k < 2; ++k) acc[ai][bj][m][n] = __builtin_amdgcn_mfma_f32_16x16x32_bf16(Bt[n][k], At[m][k], acc[ai][bj][m][n], 0, 0, 0); } } \
        __builtin_amdgcn_s_setprio(0); } while (0)
#define PG8_WAIT_V(n) asm volatile("s_waitcnt vmcnt(" #n ")" ::: "memory")
#define PG8_WAIT_L(n) asm volatile("s_waitcnt lgkmcnt(" #n ")" ::: "memory")
#define PG8_BAR __builtin_amdgcn_s_barrier()
#define PG8_SCHED __builtin_amdgcn_sched_barrier(0)
    Unit cur, nxt; int ui = 0;
    if (!S.next(0, cur)) return;
    f32x4 acc[2][2][4][2];
#pragma unroll
    for (int a = 0; a < 2; ++a)
#pragma unroll
        for (int b = 0; b < 2; ++b)
#pragma unroll
            for (int m = 0; m < 4; ++m)
#pragma unroll
                for (int n = 0; n < 2; ++n) acc[a][b][m][n] = (f32x4){0.f, 0.f, 0.f, 0.f};
    typedef int v8i_t __attribute__((ext_vector_type(8))); typedef int v4i_t __attribute__((ext_vector_type(4)));
    v8i_t At8[4], B08[2], B18[2]; bf16x8 At[4][2], B0[2][2], B1[2][2];
    const int one_scale = 0x7F7F7F7F;
    const char* cA = cur.A; const char* cB = cur.B;
    if constexpr (GATHER) { const int* rm_ = S.rowmap + cur.m0; PG8_GOFF(voffA, voffA1, rm_); }
#define voffAh1 (GATHER ? voffA1 : voffA)
    PG8_STAGE(PG8_SB(0, 0), cB, voffB); PG8_STAGE(PG8_SB(0, 1), cB + hstepB, voffB); PG8_STAGE(PG8_SA(0, 0), cA, voffA); PG8_STAGE(PG8_SA(0, 1), cA + hstepA, voffAh1);
    if (wr == 1) PG8_BAR;
    PG8_WAIT_V(2); PG8_BAR;
    PG8_STAGE(PG8_SB(1, 0), cB + kstep, voffB); PG8_STAGE(PG8_SA(1, 0), cA + kstep, voffA); PG8_STAGE(PG8_SB(1, 1), cB + hstepB + kstep, voffB);
    PG8_WAIT_V(6); PG8_BAR;
    for (;;) {
        const bool has_next = S.next(ui + 1, nxt);
        const char* nA = has_next ? nxt.A : cA; const char* nB = has_next ? nxt.B : cB;
        if constexpr (GATHER) {
            if (has_next) __builtin_amdgcn_global_load_lds((const unsigned*)(S.rowmap + nxt.m0 + (wid & 3) * 64 + lane), (LAS unsigned*)(S.idxb + ((ui + 1) & 1) * 256 + (wid & 3) * 64), 4, 0, 0);
        }
#pragma unroll 1
        for (int t = 0; t < nt; t += 2) {
            const bool last = (t == nt - 2);
            const char* a1 = cA + (size_t)(t + 1) * kstep;
            const char* a2 = last ? nA : cA + (size_t)(t + 2) * kstep; const char* b2 = last ? nB : cB + (size_t)(t + 2) * kstep;
            const char* a3 = a2 + kstep; const char* b3 = b2 + kstep;
            PG8_LDB(B0, 0, 0); PG8_LDB(B1, 0, 1); PG8_SCHED; PG8_LDA(At, 0, 0); PG8_STAGE(PG8_SA(1, 1), a1 + hstepA, voffAh1);
            if constexpr (GATHER) { if (last && has_next) { const LAS int* ib_ = S.idxb + ((ui + 1) & 1) * 256; PG8_GOFF(voffA, voffA1, ib_); } }
            PG8_WAIT_V(8); PG8_WAIT_L(0); PG8_BAR; PG8_MMA(0, 0, At, B0); PG8_MMA(0, 1, At, B1); PG8_BAR; PG8_SCHED;
            PG8_LDA(At, 0, 1); PG8_STAGE(PG8_SB(0, 0), b2, voffB); PG8_STAGE(PG8_SB(0, 1), b2 + hstepB, voffB); PG8_STAGE(PG8_SA(0, 0), a2, voffA);
            PG8_WAIT_V(8); PG8_WAIT_L(0); PG8_BAR; PG8_MMA(1, 0, At, B0); PG8_MMA(1, 1, At, B1); PG8_BAR; PG8_SCHED;
            PG8_LDB(B0, 1, 0); PG8_LDB(B1, 1, 1); PG8_SCHED; PG8_LDA(At, 1, 0); PG8_STAGE(PG8_SA(0, 1), a2 + hstepA, voffAh1);
            PG8_WAIT_V(8); PG8_WAIT_L(0); PG8_BAR; PG8_MMA(0, 0, At, B0); PG8_MMA(0, 1, At, B1); PG8_BAR; PG8_SCHED;
            PG8_LDA(At, 1, 1); PG8_STAGE(PG8_SB(1, 0), b3, voffB); PG8_STAGE(PG8_SB(1, 1), b3 + hstepB, voffB); PG8_STAGE(PG8_SA(1, 0), a3, voffA);
            PG8_WAIT_V(8); PG8_WAIT_L(0); PG8_BAR; PG8_MMA(1, 0, At, B0); PG8_MMA(1, 1, At, B1); PG8_BAR; PG8_SCHED;
        }
        if constexpr (ALIGN_EPI) { if (wr == 0) PG8_BAR; }
        if constexpr (FP8) { asm volatile("s_nop 15\n\ts_nop 15" ::: "memory"); __builtin_amdgcn_sched_barrier(0); }
        E(acc, cur, wr, wc, fr, fq);
        if (!has_next) break;
#pragma unroll
        for (int a = 0; a < 2; ++a)
#pragma unroll
            for (int b = 0; b < 2; ++b)
#pragma unroll
                for (int m = 0; m < 4; ++m)
#pragma unroll
                    for (int n = 0; n < 2; ++n) acc[a][b][m][n] = (f32x4){0.f, 0.f, 0.f, 0.f};
        cur = nxt; cA = nA; cB = nB; ++ui;
        if constexpr (ALIGN_EPI) { if (wr == 1) PG8_BAR; }
    }
    PG8_WAIT_V(0);
    if constexpr (!ALIGN_EPI) { if (wr == 0) PG8_BAR; }
    PG8_BAR;
#undef PG8_SA
#undef PG8_SB
#undef PG8_STAGE
#undef PG8_LDA
#undef PG8_LD8
#undef PG8_LDB
#undef PG8_MMA
#undef PG8_WAIT_V
#undef PG8_WAIT_L
#undef PG8_BAR
#undef PG8_SCHED
#undef PG8_GOFF
#undef voffAh1
}
}

#define XB_TMO      128
#define XB_XCNT(j)  (256  + 64 * (j))
#define XB_XSUB(j)  (1280 + 64 * (j))
#define XB_XGEN(j)  (2304 + 64 * (j))
#define XB_TOP      3328
#define XB_TOPGEN   3392
#define XCD_BAR_WORDS 3456
#define XB_SPIN_CAP (1u << 22)
__device__ __forceinline__ unsigned xb_ld(unsigned* p)              { return __hip_atomic_load(p, __ATOMIC_RELAXED, __HIP_MEMORY_SCOPE_AGENT); }
__device__ __forceinline__ unsigned xb_add(unsigned* p, unsigned v) { return __hip_atomic_fetch_add(p, v, __ATOMIC_RELAXED, __HIP_MEMORY_SCOPE_AGENT); }
__device__ __forceinline__ unsigned xb_xcc_id() { return (unsigned)__builtin_amdgcn_s_getreg((3 << 11) | 20) & 0xFu; }
#define XB_SPIN(cond, bar) do { unsigned _sp = 0; while (cond) { __builtin_amdgcn_s_sleep(1); \
    if ((++_sp & 255u) == 0u) { if (xb_ld(&(bar)[XB_TMO])) break; if (_sp > XB_SPIN_CAP) { atomicAdd(&(bar)[XB_TMO], 1u); break; } } } } while (0)
struct XcdBarrier { unsigned* bar; unsigned x; volatile LAS unsigned* st; };
__device__ __forceinline__ XcdBarrier xcd_barrier_post(unsigned* bar, volatile LAS unsigned* st) {
    XcdBarrier b; b.bar = bar; b.x = xb_xcc_id(); b.st = st;
    if (threadIdx.x == 0) (void)xb_add(&bar[XB_XCNT(b.x)], 1u);
    return b;
}
__device__ __forceinline__ void xcd_barrier_complete(unsigned* bar, unsigned x, unsigned& nloc, unsigned& nx) {
    const unsigned G = gridDim.x * gridDim.y * gridDim.z;
    unsigned sum, cnt, mine, sp = 0u;
    for (;;) {
        sum = 0u; cnt = 0u; mine = 0u;
#pragma unroll
        for (unsigned j = 0; j < 16; ++j) { const unsigned c = xb_ld(&bar[XB_XCNT(j)]); sum += c; cnt += (c > 0u) ? 1u : 0u; mine = (j == x) ? c : mine; }
        if (sum == G) break;
        __builtin_amdgcn_s_sleep(1);
        if ((++sp & 255u) == 0u) { if (xb_ld(&bar[XB_TMO])) break; if (sp > XB_SPIN_CAP) { atomicAdd(&bar[XB_TMO], 1u); break; } }
    }
    nloc = mine > 0u ? mine : 1u; nx = cnt > 0u ? cnt : 1u;
}
__device__ __forceinline__ void xcd_barrier(const XcdBarrier& b) {
    asm volatile("s_waitcnt vmcnt(0)" ::: "memory");
    __syncthreads();
    if (threadIdx.x == 0) {
        unsigned* bar = b.bar;
        __builtin_amdgcn_s_waitcnt(0);
        unsigned nloc = b.st[0], nx = b.st[1];
        if (nloc == 0u) { xcd_barrier_complete(bar, b.x, nloc, nx); b.st[0] = nloc; b.st[1] = nx; }
        const unsigned old = xb_add(&bar[XB_XSUB(b.x)], 1u);
        const unsigned gen = old / nloc;
        if (old + 1u == (gen + 1u) * nloc) {
            __builtin_amdgcn_fence(__ATOMIC_RELEASE, "agent");
            asm volatile("s_waitcnt vmcnt(0)" ::: "memory");
            const unsigned og = xb_add(&bar[XB_TOP], 1u);
            const unsigned tg = og / nx;
            if (og + 1u == (tg + 1u) * nx) xb_add(&bar[XB_TOPGEN], 1u);
            else XB_SPIN(xb_ld(&bar[XB_TOPGEN]) == tg, bar);
            __builtin_amdgcn_fence(__ATOMIC_ACQUIRE, "agent");
            xb_add(&bar[XB_XGEN(b.x)], 1u);
            asm volatile("s_waitcnt vmcnt(0)" ::: "memory");
        } else {
            XB_SPIN(xb_ld(&bar[XB_XGEN(b.x)]) == gen, bar);
            __builtin_amdgcn_fence(__ATOMIC_ACQUIRE, "agent");
            asm volatile("s_waitcnt vmcnt(0)" ::: "memory");
        }
    }
    __syncthreads();
}

struct Args {
    const float* x; const float* mem; const int* positions; const float* norm_mix; const float* w_in; const float* kv_norm; const float* idx_k_norm;
    const float* w_uk; const float* w_uv; const float* rel_bias; const float* w_out; const float* norm_cross; const float* norm_mem;
    const float* w_cq; const float* w_ck; const float* w_cv; const float* w_co; const float* norm_ffn; const float* w_router; const float* b_router;
    const float* w_gu; const float* b_gu; const float* w_down; const float* b_down; const float* norm_final;
    float* out; unsigned char* ws; int ph_lo, ph_hi; int use_bar, pad;
};

template <class Map>
__device__ __forceinline__ void transpose_item(const float* W, int ldw, bf16* WT, int ldt, int k0, int n0, LAS float* scr, int lane, Map map, const float* rs = nullptr) {
    const int c = lane & 31; const int src = map(n0 + c);
#pragma unroll 8
    for (int i = 0; i < 32; ++i) { const int kk = 2 * i + (lane >> 5); scr[kk * 33 + c] = (src >= 0) ? W[(size_t)(k0 + kk) * ldw + src] * (rs ? rs[k0 + kk] : 1.0f) : 0.f; }
    LDS_WAIT();
    const int ch = lane & 7;
#pragma unroll
    for (int j = 0; j < 4; ++j) { const int n = (lane >> 3) + 8 * j; const LAS float* s = scr + (8 * ch) * 33 + n;
        u32x4 o; o.x = pk2(s[0 * 33], s[1 * 33]); o.y = pk2(s[2 * 33], s[3 * 33]); o.z = pk2(s[4 * 33], s[5 * 33]); o.w = pk2(s[6 * 33], s[7 * 33]);
        *(u32x4*)(WT + (size_t)(n0 + n) * ldt + k0 + 8 * ch) = o; }
    LDS_WAIT();
}
template <class Map>
__device__ __forceinline__ void t8_load(f32x4 (&v)[16], const float* W, int ldw, int k0, int n0, int lane, Map map) {
    const int c4 = (lane & 7) * 4; const int src = map(n0 + c4);
#pragma unroll
    for (int i = 0; i < 16; ++i) v[i] = *(const f32x4*)(W + (size_t)(k0 + 8 * i + (lane >> 3)) * ldw + src);
}
__device__ __forceinline__ void t8_finish(const f32x4 (&v)[16], unsigned char* WT, int ldt, int k0, int n0, LAS float* scr, int lane, float sc) {
    const int c4 = (lane & 7) * 4;
#pragma unroll
    for (int i = 0; i < 16; ++i) { LAS float* d = scr + (8 * i + (lane >> 3)) * 33 + c4; d[0] = v[i].x * sc; d[1] = v[i].y * sc; d[2] = v[i].z * sc; d[3] = v[i].w * sc; }
    LDS_WAIT();
    const int ch = lane & 7;
#pragma unroll
    for (int j = 0; j < 4; ++j) { const int n = (lane >> 3) + 8 * j; const LAS float* s = scr + (16 * ch) * 33 + n;
        u32x4 o; o.x = pk4_fp8(s[0 * 33], s[1 * 33], s[2 * 33], s[3 * 33]); o.y = pk4_fp8(s[4 * 33], s[5 * 33], s[6 * 33], s[7 * 33]);
        o.z = pk4_fp8(s[8 * 33], s[9 * 33], s[10 * 33], s[11 * 33]); o.w = pk4_fp8(s[12 * 33], s[13 * 33], s[14 * 33], s[15 * 33]);
        *(u32x4*)(WT + (size_t)(n0 + n) * ldt + k0 + 16 * ch) = o; }
    LDS_WAIT();
}
__device__ __forceinline__ void rms_row_fp8(const float* xrow, const float* gain, unsigned char* orow, int lane, float sc) {
    const f32x4* xr = (const f32x4*)xrow + lane; const f32x4* gr = (const f32x4*)gain + lane;
    f32x4 v[8]; float s = 0.f;
#pragma unroll
    for (int j = 0; j < 8; ++j) { v[j] = xr[64 * j]; s += (v[j].x * v[j].x + v[j].y * v[j].y) + (v[j].z * v[j].z + v[j].w * v[j].w); }
    const float rstd = rsqrtf(wave_sum(s) * (1.f / DM) + EPS) * sc;
    unsigned* o4 = (unsigned*)orow + lane;
#pragma unroll
    for (int j = 0; j < 8; ++j) { const f32x4 g = gr[64 * j]; o4[64 * j] = pk4_fp8(v[j].x * rstd * g.x, v[j].y * rstd * g.y, v[j].z * rstd * g.z, v[j].w * rstd * g.w); }
}
__device__ __forceinline__ void rms_hrow_bf16(const bf16* hrow, const float* gain, bf16* orow, int lane) {
    const u32x2* xr = (const u32x2*)hrow + lane; const f32x4* gr = (const f32x4*)gain + lane;
    f32x4 v[8]; float s = 0.f;
#pragma unroll
    for (int j = 0; j < 8; ++j) { const u32x2 w = xr[64 * j]; v[j] = (f32x4){bflo(w.x), bfhi(w.x), bflo(w.y), bfhi(w.y)}; s += (v[j].x * v[j].x + v[j].y * v[j].y) + (v[j].z * v[j].z + v[j].w * v[j].w); }
    const float rstd = rsqrtf(wave_sum(s) * (1.f / DM) + EPS);
    u32x2* o8 = (u32x2*)orow + lane;
#pragma unroll
    for (int j = 0; j < 8; ++j) { const f32x4 g = gr[64 * j]; o8[64 * j] = (u32x2){pk2(v[j].x * rstd * g.x, v[j].y * rstd * g.y), pk2(v[j].z * rstd * g.z, v[j].w * rstd * g.w)}; }
}
__device__ __forceinline__ void rms_hrow_fp8(const bf16* hrow, const float* gain, unsigned char* orow, int lane, float sc) {
    const u32x2* xr = (const u32x2*)hrow + lane; const f32x4* gr = (const f32x4*)gain + lane;
    f32x4 v[8]; float s = 0.f;
#pragma unroll
    for (int j = 0; j < 8; ++j) { const u32x2 w = xr[64 * j]; v[j] = (f32x4){bflo(w.x), bfhi(w.x), bflo(w.y), bfhi(w.y)}; s += (v[j].x * v[j].x + v[j].y * v[j].y) + (v[j].z * v[j].z + v[j].w * v[j].w); }
    const float rstd = rsqrtf(wave_sum(s) * (1.f / DM) + EPS) * sc;
    unsigned* o4 = (unsigned*)orow + lane;
#pragma unroll
    for (int j = 0; j < 8; ++j) { const f32x4 g = gr[64 * j]; o4[64 * j] = pk4_fp8(v[j].x * rstd * g.x, v[j].y * rstd * g.y, v[j].z * rstd * g.z, v[j].w * rstd * g.w); }
}
__device__ __forceinline__ void rms_row_bf16(const float* xrow, const float* gain, bf16* orow, int lane) {
    const f32x4* xr = (const f32x4*)xrow + lane; const f32x4* gr = (const f32x4*)gain + lane;
    f32x4 v[8]; float s = 0.f;
#pragma unroll
    for (int j = 0; j < 8; ++j) { v[j] = xr[64 * j]; s += (v[j].x * v[j].x + v[j].y * v[j].y) + (v[j].z * v[j].z + v[j].w * v[j].w); }
    const float rstd = rsqrtf(wave_sum(s) * (1.f / DM) + EPS);
    unsigned long long* o8 = (unsigned long long*)orow + lane;
#pragma unroll
    for (int j = 0; j < 8; ++j) { const f32x4 g = gr[64 * j];
        o8[64 * j] = (unsigned long long)pk2(v[j].x * rstd * g.x, v[j].y * rstd * g.y) | ((unsigned long long)pk2(v[j].z * rstd * g.z, v[j].w * rstd * g.w) << 32); }
}
__device__ __forceinline__ int t5_bucket(int dist) {
    const int n = dist > 0 ? dist : 0;
    if (n < 16) return n;
    const float nf = (float)n;
    int large = 16 + (int)(logf(nf / 16.0f) / 2.0794415416798357f * 16.0f);
    return large < 31 ? large : 31;
}

struct CvtJob { const float* gu_src; const float* dn_src; unsigned char* gu_dst; unsigned char* dn_dst; };
__device__ __forceinline__ CvtJob cvt_job(const float* w_gu, const float* w_down, unsigned char* w_gu8, unsigned char* w_d8, int gwave, int lane) {
    const int e = gwave >> 6, nb = gwave & 63; CvtJob J;
    const int n = 64 * nb + lane;
    const int src = ((n & 255) < 128) ? 128 * (n >> 8) + (n & 127) : DFF + 128 * (n >> 8) + (n & 127);
    J.gu_src = w_gu + (size_t)e * DM * 2 * DFF + src; J.gu_dst = w_gu8 + (size_t)e * 2 * DFF * DM + (size_t)n * DM;
    const int n2 = 64 * (nb >> 1) + lane;
    J.dn_src = w_down + (size_t)e * DFF * DM + (size_t)(1024 * (nb & 1)) * DM + n2; J.dn_dst = w_d8 + (size_t)e * DM * DFF + (size_t)n2 * DFF + 1024 * (nb & 1);
    return J;
}
constexpr int CVT_ITEMS = 192;
#define CVT_ISSUE(R, j_) do { const int jc_ = (j_) < CVT_ITEMS ? (j_) : CVT_ITEMS - 1; const bool gu_ = jc_ < 128; const float* sp_ = gu_ ? J.gu_src + (size_t)(16 * jc_) * (2 * DFF) : J.dn_src + (size_t)(16 * (jc_ - 128)) * DM; \
        const size_t st_ = gu_ ? (size_t)(2 * DFF) : (size_t)DM; _Pragma("unroll") for (int i_ = 0; i_ < 16; ++i_) R[i_] = __builtin_nontemporal_load(sp_ + i_ * st_); } while (0)
#define CVT_DONE(R, j_) do { if ((j_) < CVT_ITEMS) { unsigned char* dp_ = ((j_) < 128) ? J.gu_dst + 16 * (j_) : J.dn_dst + 16 * ((j_) - 128); \
        *(u32x4*)dp_ = (u32x4){pk4_fp8(R[0] * FP8_WS, R[1] * FP8_WS, R[2] * FP8_WS, R[3] * FP8_WS), pk4_fp8(R[4] * FP8_WS, R[5] * FP8_WS, R[6] * FP8_WS, R[7] * FP8_WS), \
                               pk4_fp8(R[8] * FP8_WS, R[9] * FP8_WS, R[10] * FP8_WS, R[11] * FP8_WS), pk4_fp8(R[12] * FP8_WS, R[13] * FP8_WS, R[14] * FP8_WS, R[15] * FP8_WS)}; } } while (0)

__device__ __forceinline__ void idx_phase(const bf16* proj, const unsigned char* kfrag, int* sel, int* nsel, lds_t* lds, const int tid, const int lane, const int wave, const int bx, const int G,
                                          const bool do_cvt, const float* w_gu, const float* w_down, unsigned char* w_gu8, unsigned char* w_d8) {
    typedef __bf16 bf16x2_t __attribute__((ext_vector_type(2))); typedef short s16x2_t __attribute__((ext_vector_type(2)));
    LAS float* Sc = (LAS float*)lds;
    LAS unsigned* hist1 = (LAS unsigned*)(lds + 131072);
    LAS int* mm = (LAS int*)(lds + 155648);
    LAS unsigned* cnts = (LAS unsigned*)(lds + 155648 + 256);
    LAS int* cand = (LAS int*)(lds + 147456);
    for (int i = tid; i < 4096; i += NTHREADS) hist1[i] = 0u;
    if (tid < 4) { cnts[tid] = 0u; mm[2 * tid] = 0x7fffffff; mm[2 * tid + 1] = (int)0x80000000; }
    __syncthreads();
    const int r32 = lane & 31, hi = lane >> 5;
#define F2ORD(f) ({ const int b__ = __float_as_int(f); b__ ^ ((b__ >> 31) & 0x7fffffff); })
    typedef int v8i_t __attribute__((ext_vector_type(8)));
    bf16x8 Af[2][4], Wp[2][2]; v8i_t Af8[2];
#define IDX_FRAGS(gq_) do { const int b_ = (gq_) >> 11, t0_ = ((gq_) & 2047) * 4, rb_ = b_ * SEQ; \
        _Pragma("unroll") for (int rg_ = 0; rg_ < 2; ++rg_) { const int qrow_ = rb_ + t0_ + 2 * rg_ + ((r32 >> 2) & 1), head_ = (r32 & 3) + 4 * (r32 >> 3); \
            const bf16* ap_ = proj + (size_t)qrow_ * NPROJ + C_QIDX + head_ * 64 + 32 * hi; \
            _Pragma("unroll") for (int ks_ = 0; ks_ < 4; ++ks_) Af[rg_][ks_] = *(const bf16x8*)(ap_ + 8 * ks_); \
            const bf16* wp_ = proj + (size_t)(rb_ + t0_ + 2 * rg_ + hi) * NPROJ + C_WIDX; Wp[rg_][0] = *(const bf16x8*)wp_; Wp[rg_][1] = *(const bf16x8*)(wp_ + 8); } \
        } while (0)
    bool havepf = false;
    const CvtJob J = cvt_job(w_gu, w_down, w_gu8, w_d8, bx * NWAVES + wave, lane);
    int cj = do_cvt ? 0 : CVT_ITEMS;
    for (int gq = bx; gq < T / 4; gq += G) {
        const int b = gq >> 11, t0 = (gq & 2047) * 4; const int rowbase = b * SEQ;
        if (t0 < 256) {
            for (int i = tid; i < 1024; i += NTHREADS) { const int q = i >> 8, j = i & 255, t = t0 + q; sel[(size_t)(rowbase + t) * 256 + j] = (j <= t) ? j : 0; }
            if (tid < 4) nsel[rowbase + t0 + tid] = t0 + tid + 1;
            continue;
        }
        if (!havepf) IDX_FRAGS(gq);
#pragma unroll
        for (int rg = 0; rg < 2; ++rg)
#pragma unroll
            for (int ks = 0; ks < 4; ++ks) { const u32x4 w = __builtin_bit_cast(u32x4, Af[rg][ks]);
                Af8[rg][2 * ks] = (int)pk4_fp8(bflo(w.x) * IDX_QS, bfhi(w.x) * IDX_QS, bflo(w.y) * IDX_QS, bfhi(w.y) * IDX_QS); Af8[rg][2 * ks + 1] = (int)pk4_fp8(bflo(w.z) * IDX_QS, bfhi(w.z) * IDX_QS, bflo(w.w) * IDX_QS, bfhi(w.w) * IDX_QS); }
        float mn[2] = {INFINITY, INFINITY}, mx[2] = {-INFINITY, -INFINITY};
        const int ntile = (t0 + 4 + 31) >> 5;
        const unsigned char* kf = kfrag + (size_t)b * 256 * 2048 + lane * 16;
#define IDX_LOAD(B, kt0) do { _Pragma("unroll") for (int j_ = 0; j_ < IDX_NB; ++j_) { int kt_ = (kt0) + 8 * j_; kt_ = kt_ < ntile ? kt_ : ntile - 1; \
            _Pragma("unroll") for (int kp_ = 0; kp_ < 2; ++kp_) B[j_][kp_] = *(const u32x4*)(kf + ((size_t)kt_ * 2 + kp_) * 1024); } } while (0)
#define IDX_DUMP ((155648 + 1024) / 4)
#define IDX_RELU(x) __builtin_amdgcn_fmed3f((x), 0.0f, 3.0e38f)
#define IDX_PK(lo, hi_) __builtin_bit_cast(unsigned, __builtin_convertvector((f32x2){IDX_RELU(lo), IDX_RELU(hi_)}, bf16x2_t))
#define IDX_ONE(Bj, kt_, rg_) do { const int key_ = (kt_) * 32 + r32; f32x16 a0_ = {}; \
                a0_ = __builtin_amdgcn_mfma_scale_f32_32x32x64_f8f6f4(Af8[rg_], __builtin_bit_cast(v8i_t, __builtin_shufflevector(Bj[0], Bj[1], 0, 1, 2, 3, 4, 5, 6, 7)), a0_, 0, 0, 0, 0x7F7F7F7F, 0, 0x7F7F7F7F);     \
                  \
                  \
                float sd_ = 0.f; const u32x4 wa_ = __builtin_bit_cast(u32x4, Wp[rg_][0]), wb_ = __builtin_bit_cast(u32x4, Wp[rg_][1]); \
                const unsigned wv_[8] = {wa_.x, wa_.y, wa_.z, wa_.w, wb_.x, wb_.y, wb_.z, wb_.w}; \
                _Pragma("unroll") for (int i_ = 0; i_ < 8; ++i_) { const s16x2_t p_ = __builtin_elementwise_max(__builtin_bit_cast(s16x2_t, __builtin_convertvector((f32x2){a0_[2 * i_], a0_[2 * i_ + 1]}, bf16x2_t)), (s16x2_t){0, 0}); \
                    sd_ = __builtin_amdgcn_fdot2_f32_bf16(__builtin_bit_cast(bf16x2_t, p_), __builtin_bit_cast(bf16x2_t, wv_[i_]), sd_, false); } \
                const float s0_ = sd_ * 0.03125f; \
                { const bool ok_ = key_ <= t0 + 2 * rg_ + hi;     \
                  Sc[ok_ ? (2 * rg_ + hi) * 8192 + key_ : IDX_DUMP] = s0_; mn[rg_] = fminf(mn[rg_], ok_ ? s0_ : INFINITY); mx[rg_] = fmaxf(mx[rg_], ok_ ? s0_ : -INFINITY); } } while (0)
#define IDX_COMP(B, kt0) do { if ((kt0) + 8 < ntile) { IDX_ONE(B[0], (kt0), 0); IDX_ONE(B[1], (kt0) + 8, 0); IDX_ONE(B[0], (kt0), 1); IDX_ONE(B[1], (kt0) + 8, 1); } \
            else if ((kt0) < ntile) { IDX_ONE(B[0], (kt0), 0); IDX_ONE(B[0], (kt0), 1); } } while (0)
#if defined(PROBE_SCORE2)
        for (int rep_ = 0; rep_ < 2; ++rep_)
#endif
        {
            u32x4 Ba[IDX_NB][2], Bb[IDX_NB][2];
            int kt0 = wave;
            IDX_LOAD(Ba, kt0);
            while (kt0 < ntile) {
                IDX_LOAD(Bb, kt0 + 8 * IDX_NB); IDX_COMP(Ba, kt0); kt0 += 8 * IDX_NB;
                if (kt0 >= ntile) break;
                IDX_LOAD(Ba, kt0 + 8 * IDX_NB); IDX_COMP(Bb, kt0); kt0 += 8 * IDX_NB;
            }
        }
#undef IDX_LOAD
#undef IDX_COMP
#undef IDX_ONE
#undef IDX_PK
#undef IDX_DUMP
#undef IDX_RELU
        { const int gn = gq + G; havepf = (gn < T / 4) && (((gn & 2047) * 4) >= 256); if (havepf) IDX_FRAGS(gn); }
#pragma unroll
        for (int rg = 0; rg < 2; ++rg) {
            float rn = mn[rg], rx = mx[rg];
#define IDX_DPPF(v_, ctrl_, rmask_) __builtin_bit_cast(float, __builtin_amdgcn_update_dpp(__builtin_bit_cast(int, v_), __builtin_bit_cast(int, v_), (ctrl_), (rmask_), 0xf, false))
            rn = fminf(rn, IDX_DPPF(rn, 0x111, 0xf)); rx = fmaxf(rx, IDX_DPPF(rx, 0x111, 0xf));
            rn = fminf(rn, IDX_DPPF(rn, 0x112, 0xf)); rx = fmaxf(rx, IDX_DPPF(rx, 0x112, 0xf));
            rn = fminf(rn, IDX_DPPF(rn, 0x114, 0xf)); rx = fmaxf(rx, IDX_DPPF(rx, 0x114, 0xf));
            rn = fminf(rn, IDX_DPPF(rn, 0x118, 0xf)); rx = fmaxf(rx, IDX_DPPF(rx, 0x118, 0xf));
            rn = fminf(rn, IDX_DPPF(rn, 0x142, 0xa)); rx = fmaxf(rx, IDX_DPPF(rx, 0x142, 0xa));
#undef IDX_DPPF
            if ((lane & 31) == 31) {
                __hip_atomic_fetch_min(mm + 2 * (2 * rg + hi), F2ORD(rn), __ATOMIC_RELAXED, __HIP_MEMORY_SCOPE_WORKGROUP);
                __hip_atomic_fetch_max(mm + 2 * (2 * rg + hi) + 1, F2ORD(rx), __ATOMIC_RELAXED, __HIP_MEMORY_SCOPE_WORKGROUP); }
        }
        float cva[16], cvb[16], cvc[16], cvd[16], cve[16], cvf[16];
        CVT_ISSUE(cva, cj);
        __syncthreads();
        int ln = lane; asm volatile("" : "+v"(ln));
        const int q = wave >> 1, P = wave & 1, nq = t0 + q + 1, nch = (nq + 63) >> 6;
        const int nh = (nch + 1) >> 1, cbeg = P * nh, cend = (cbeg + nh < nch) ? cbeg + nh : nch;
        const int imn_ = mm[2 * q], imx_ = mm[2 * q + 1];
        const float vmin = __int_as_float(imn_ ^ ((imn_ >> 31) & 0x7fffffff)), vmax = __int_as_float(imx_ ^ ((imx_ >> 31) & 0x7fffffff));
        const float range = vmax - vmin; const float kscale = range > 0.f ? 1048576.0f / range : 0.f;
        LAS float* Sq = Sc + q * 8192; LAS int* Kq = (LAS int*)Sq; LAS unsigned* h1q = hist1 + q * 1024;
#define P1_ELEM(v_, s_) do { int k_ = (int)(((v_) - vmin) * kscale); k_ = k_ < 0 ? 0 : k_; k_ = k_ > 1048575 ? 1048575 : k_; Kq[(s_)] = k_; \
            __hip_atomic_fetch_add(h1q + (k_ >> 10), 1u, __ATOMIC_RELAXED, __HIP_MEMORY_SCOPE_WORKGROUP); } while (0)
        const int nfull = nq >> 6;
        const int cfe = cend < nfull ? cend : nfull;
        { int c = cbeg;
          for (; c + 4 <= cfe; c += 4) { float v_[4];
#pragma unroll
              for (int u = 0; u < 4; ++u) v_[u] = Sq[64 * (c + u) + ln];
#pragma unroll
              for (int u = 0; u < 4; ++u) P1_ELEM(v_[u], 64 * (c + u) + ln); }
          for (; c < cfe; ++c) { const float v1_ = Sq[64 * c + ln]; P1_ELEM(v1_, 64 * c + ln); }
          for (; c < cend; ++c) { const int s = 64 * c + ln; if (s < nq) { const float v1_ = Sq[s]; P1_ELEM(v1_, s); } } }
#undef P1_ELEM
        CVT_ISSUE(cvb, cj + 1); CVT_ISSUE(cvc, cj + 2);
        __syncthreads();
        int B1; unsigned cgt1;
        { unsigned h_[16];
          const u32x4 h0 = *(const LAS u32x4*)(h1q + 16 * ln), h1v = *(const LAS u32x4*)(h1q + 16 * ln + 4), h2v = *(const LAS u32x4*)(h1q + 16 * ln + 8), h3v = *(const LAS u32x4*)(h1q + 16 * ln + 12);
          h_[0] = h0.x; h_[1] = h0.y; h_[2] = h0.z; h_[3] = h0.w; h_[4] = h1v.x; h_[5] = h1v.y; h_[6] = h1v.z; h_[7] = h1v.w; h_[8] = h2v.x; h_[9] = h2v.y; h_[10] = h2v.z; h_[11] = h2v.w; h_[12] = h3v.x; h_[13] = h3v.y; h_[14] = h3v.z; h_[15] = h3v.w;
          unsigned tot_ = 0;
#pragma unroll
          for (int j_ = 0; j_ < 16; ++j_) tot_ += h_[j_];
          unsigned suf_ = tot_;
#pragma unroll
          for (int o_ = 1; o_ < 64; o_ <<= 1) { const unsigned t_ = __shfl_down(suf_, o_); if (ln + o_ < 64) suf_ += t_; }
          unsigned cum_ = suf_ - tot_; int bin_ = -1; unsigned cg_ = 0;
#pragma unroll
          for (int j_ = 15; j_ >= 0; --j_) { const bool hit_ = (bin_ < 0) && (cum_ + h_[j_] >= 256u); if (hit_) { bin_ = 16 * ln + j_; cg_ = cum_; } cum_ += h_[j_]; }
          const bool mine_ = (suf_ - tot_) < 256u && 256u <= suf_; const unsigned long long mk_ = __ballot(mine_);
          const int src_ = mk_ ? (int)__builtin_ctzll(mk_) : 0; B1 = __shfl(bin_, src_); cgt1 = (unsigned)__shfl((int)cg_, src_); if (!mk_) { B1 = 0; cgt1 = 0; } }
        CVT_ISSUE(cvd, cj + 3); CVT_ISSUE(cve, cj + 4);
        const unsigned r1 = 256u - cgt1;
        int* outp = sel + (size_t)(rowbase + t0 + q) * 256;
        const unsigned long long ltmask = (1ull << ln) - 1ull, gtmask = ~((2ull << ln) - 1ull);
        unsigned run = 0;
#define P2_CHUNK(K_, s_) do { const int kb_ = (K_) < 0 ? -1 : ((K_) >> 10); const bool em_ = kb_ > B1, cd_ = kb_ == B1; \
            const unsigned long long me_ = __ballot(em_); \
            if (me_) { const unsigned pos_ = P ? (cgt1 - 1u - run - (unsigned)__builtin_popcountll(me_ & gtmask)) : (run + (unsigned)__builtin_popcountll(me_ & ltmask)); \
                if (em_ && pos_ < 256u) outp[pos_] = (s_); run += (unsigned)__builtin_popcountll(me_); } \
            const unsigned long long mc_ = __ballot(cd_); \
            if (mc_) { unsigned base_ = 0; if (ln == 0) base_ = __hip_atomic_fetch_add(cnts + q, (unsigned)__builtin_popcountll(mc_), __ATOMIC_RELAXED, __HIP_MEMORY_SCOPE_WORKGROUP); \
                base_ = __builtin_amdgcn_readfirstlane(base_); const unsigned pos_ = base_ + (unsigned)__builtin_popcountll(mc_ & ltmask); \
                if (cd_ && pos_ < 256u) { cand[(q * 256 + pos_) * 2] = (s_); cand[(q * 256 + pos_) * 2 + 1] = (K_); } } } while (0)
        if (P == 0) {
            int c = cbeg;
            for (; c + 4 <= cend; c += 4) { int k_[4];
#pragma unroll
                for (int u = 0; u < 4; ++u) k_[u] = Kq[64 * (c + u) + ln];
#pragma unroll
                for (int u = 0; u < 4; ++u) P2_CHUNK(k_[u], 64 * (c + u) + ln); }
            for (; c < cend; ++c) { const int k1_ = Kq[64 * c + ln]; P2_CHUNK(k1_, 64 * c + ln); }
        } else {
            int c = cend - 1;
            if (c >= cbeg && c >= nfull) { const int s = 64 * c + ln; const int k1_ = (s < nq) ? Kq[64 * (c & 127) + ln] : -1; P2_CHUNK(k1_, s); --c; }
            for (; c - 3 >= cbeg; c -= 4) { int k_[4];
#pragma unroll
                for (int u = 0; u < 4; ++u) k_[u] = Kq[64 * (c - u) + ln];
#pragma unroll
                for (int u = 0; u < 4; ++u) P2_CHUNK(k_[u], 64 * (c - u) + ln); }
            for (; c >= cbeg; --c) { const int k1_ = Kq[64 * c + ln]; P2_CHUNK(k1_, 64 * c + ln); }
        }
#undef P2_CHUNK
        CVT_ISSUE(cvf, cj + 5);
        __syncthreads();
        if (P == 0) {
            const unsigned nc = cnts[q] < 256u ? cnts[q] : 256u;
            const unsigned take = r1 < nc ? r1 : nc;
            for (int m4 = 0; m4 < 4; ++m4) { const unsigned i = ln + 64 * m4; if (i < nc) { const int myi = cand[(q * 256 + i) * 2], myk = cand[(q * 256 + i) * 2 + 1]; unsigned rank = 0;
                    for (unsigned j = 0; j < nc; ++j) { const int oi = cand[(q * 256 + j) * 2], ok = cand[(q * 256 + j) * 2 + 1]; rank += (ok > myk || (ok == myk && oi < myi)) ? 1u : 0u; }
                    if (rank < take) outp[cgt1 + rank] = myi; } }
            if (ln == 0) nsel[rowbase + t0 + q] = (int)(cgt1 + take);
            LDS_WAIT();
            if (ln == 0) { cnts[q] = 0u; mm[2 * q] = 0x7fffffff; mm[2 * q + 1] = (int)0x80000000; }
        }
        for (int i = tid; i < 4096; i += NTHREADS) hist1[i] = 0u;
        CVT_DONE(cva, cj); CVT_DONE(cvb, cj + 1); CVT_DONE(cvc, cj + 2); CVT_DONE(cvd, cj + 3); CVT_DONE(cve, cj + 4); CVT_DONE(cvf, cj + 5); cj = (cj + 6 < CVT_ITEMS) ? cj + 6 : CVT_ITEMS;
        __syncthreads();
    }
    for (; cj < CVT_ITEMS; cj += 2) { float cva[16], cvb[16]; CVT_ISSUE(cva, cj); CVT_ISSUE(cvb, cj + 1); CVT_DONE(cva, cj); CVT_DONE(cvb, cj + 1); }
}
#undef IDX_FRAGS
#undef F2ORD

__device__ __forceinline__ void sattn_phase(const unsigned char* ckv, const bf16* qlat, bf16* olat, const int* sel, const int* nsel, const int* positions, const float* rel_bias, lds_t* lds, const int tid, const int lane, const int wave, const int gw, const int NGW) {
    typedef __bf16 bf16x2_t __attribute__((ext_vector_type(2)));
    lds_t* buf = lds + wave * 16384;
    LAS unsigned char* bkb = (LAS unsigned char*)(lds + 131072 + wave * 256);
    LAS float* btab = (LAS float*)(lds + 131072 + 2048);
    if (tid < 256) btab[tid] = rel_bias[tid] * LOG2E;
    __syncthreads();
    const int head = lane & 15, g = lane >> 4, m15 = lane & 15;
    DECL_TRB(trb);
    unsigned wro[2][4];
    if (gw >= T) return;
    int cntN = nsel[gw], posqN = positions[gw]; int selN[4];
#pragma unroll
    for (int m4 = 0; m4 < 4; ++m4) selN[m4] = sel[(size_t)gw * 256 + lane + 64 * m4];
    (void)wro;
    for (int qi = gw; qi < T; qi += NGW) {
        const int b = qi >> 13; const int rowbase = b * SEQ;
        const int cnt = cntN, posq = posqN; const int nchunk = (cnt + 31) >> 5;
        int selv[4];
#pragma unroll
        for (int m4 = 0; m4 < 4; ++m4) selv[m4] = (lane + 64 * m4 < cnt) ? selN[m4] : 0;
        { const int qn = (qi + NGW < T) ? qi + NGW : qi;
          cntN = nsel[qn]; posqN = positions[qn];
#pragma unroll
          for (int m4 = 0; m4 < 4; ++m4) selN[m4] = sel[(size_t)qn * 256 + lane + 64 * m4]; }
        int pk[4];
#pragma unroll
        for (int m4 = 0; m4 < 4; ++m4) pk[m4] = positions[rowbase + selv[m4]];
#define SA_GATHER(RAW, ch_) do { const int chc_ = (ch_) < nchunk ? (ch_) : nchunk - 1; \
            const int v01_ = (chc_ & 2) ? selv[1] : selv[0], v23_ = (chc_ & 2) ? selv[3] : selv[2]; const int vv_ = (chc_ & 4) ? v23_ : v01_; \
            _Pragma("unroll") for (int rb_ = 0; rb_ < 2; ++rb_) { const int row_ = 8 * (m15 >> 2) + 4 * rb_ + (m15 & 3); const int idx_ = __shfl(vv_, (chc_ & 1) * 32 + row_); \
                const unsigned char* rp_ = ckv + (size_t)(rowbase + idx_) * 256 + 16 * g; \
                _Pragma("unroll") for (int j_ = 0; j_ < 4; ++j_) RAW[rb_][j_] = *(const u32x4*)(rp_ + 64 * j_); } } while (0)
        u32x4 rawA[2][4], rawB[2][4];
        SA_GATHER(rawA, 0);
#pragma unroll
        for (int m4 = 0; m4 < 4; ++m4) bkb[lane + 64 * m4] = (unsigned char)t5_bucket(posq - pk[m4]);
        bf16x8 Qf[8];
#pragma unroll
        for (int s = 0; s < 8; ++s) { Qf[s] = (bf16x8){0, 0, 0, 0, 0, 0, 0, 0}; if (head < 8) Qf[s] = *(const bf16x8*)(qlat + (size_t)qi * 2048 + head * 256 + 64 * (s >> 1) + 16 * g + 8 * (s & 1)); }
        float m_run = -INFINITY, l_run = 0.f;
        f32x4 oacc[16];
#pragma unroll
        for (int c = 0; c < 16; ++c) oacc[c] = (f32x4){0.f, 0.f, 0.f, 0.f};
#define SA_CVT(w_) ((unsigned)__builtin_bit_cast(unsigned, __builtin_amdgcn_cvt_scalef32_pk_bf16_fp8((int)(w_), 1.0f, false))), ((unsigned)__builtin_bit_cast(unsigned, __builtin_amdgcn_cvt_scalef32_pk_bf16_fp8((int)(w_), 1.0f, true)))
#define SA_CHUNK(RAW, ch) do { \
            f32x4 sc[2]; \
            _Pragma("unroll") for (int rb = 0; rb < 2; ++rb) { sc[rb] = (f32x4){0.f, 0.f, 0.f, 0.f}; const unsigned row = 8u * (m15 >> 2) + 4u * rb + (m15 & 3); \
                _Pragma("unroll") for (int j = 0; j < 4; ++j) { \
                    const u32x4 f0 = (u32x4){SA_CVT(RAW[rb][j].x), SA_CVT(RAW[rb][j].y)}, f1 = (u32x4){SA_CVT(RAW[rb][j].z), SA_CVT(RAW[rb][j].w)}; \
                    const unsigned chn = 8u * j + 2u * g; lds_t* im = buf + (chn >> 4) * 8192; \
                    *(LAS u32x4*)(im + off_b(row, chn & 15u)) = f0; *(LAS u32x4*)(im + off_b(row, (chn & 15u) + 1u)) = f1; \
                    sc[rb] = __builtin_amdgcn_mfma_f32_16x16x32_bf16(__builtin_bit_cast(bf16x8, f0), Qf[2 * j], sc[rb], 0, 0, 0); \
                    sc[rb] = __builtin_amdgcn_mfma_f32_16x16x32_bf16(__builtin_bit_cast(bf16x8, f1), Qf[2 * j + 1], sc[rb], 0, 0, 0); } } \
            const unsigned long long bk8 = *(const LAS unsigned long long*)(bkb + (ch) * 32 + 8 * g); \
            float sv[8]; float cmax = -INFINITY; \
            _Pragma("unroll") for (int rb = 0; rb < 2; ++rb) _Pragma("unroll") for (int r = 0; r < 4; ++r) { const int j8 = 4 * rb + r; const int kidx = (ch) * 32 + 8 * g + j8; const unsigned bkt = (unsigned)(bk8 >> (8 * j8)) & 0xffu; \
                    (void)kidx; sv[j8] = sc[rb][r] * (LOG2E / CKV_S) + btab[(bkt & 31u) * 8 + (head & 7)]; } \
            if ((ch) == nchunk - 1) { _Pragma("unroll") for (int j8 = 0; j8 < 8; ++j8) sv[j8] = ((ch) * 32 + 8 * g + j8 < cnt) ? sv[j8] : -INFINITY; }     \
            _Pragma("unroll") for (int j8 = 0; j8 < 8; ++j8) cmax = fmaxf(cmax, sv[j8]); \
            cmax = fmaxf(cmax, __shfl_xor(cmax, 16)); cmax = fmaxf(cmax, __shfl_xor(cmax, 32)); \
            const float m_new = fmaxf(m_run, cmax); const float m_use = (m_new == -INFINITY) ? 0.f : m_new; \
            const float alpha = __builtin_amdgcn_exp2f(m_run - m_use); \
            float ps = 0.f; float p[8]; \
            _Pragma("unroll") for (int j8 = 0; j8 < 8; ++j8) { p[j8] = __builtin_amdgcn_exp2f(sv[j8] - m_use); ps += p[j8]; } \
            l_run = l_run * alpha + ps; \
            if (!__all(m_new == m_run)) { _Pragma("unroll") for (int c = 0; c < 16; ++c) oacc[c] = oacc[c] * alpha; }     \
            m_run = m_new; \
            const u32x4 pw = (u32x4){pk2(p[0], p[1]), pk2(p[2], p[3]), pk2(p[4], p[5]), pk2(p[6], p[7])}; \
            const bf16x8 Pf = __builtin_bit_cast(bf16x8, pw); \
            asm volatile("s_waitcnt lgkmcnt(0)" ::: "memory"); \
            _Pragma("unroll") for (int c = 0; c < 16; ++c) { const lds_t* im = buf + (c >> 3) * 8192; \
                const bf16x8 A = cat4(tr_read(im + trb[0][c & 7]), tr_read(im + trb[1][c & 7])); \
                oacc[c] = __builtin_amdgcn_mfma_f32_16x16x32_bf16(A, Pf, oacc[c], 0, 0, 0); } \
            asm volatile("s_waitcnt lgkmcnt(0)" ::: "memory"); \
            __builtin_amdgcn_sched_barrier(0); } while (0)
        for (int ch = 0; ch < nchunk; ch += 2) {
            SA_GATHER(rawB, ch + 1);
            SA_CHUNK(rawA, ch);
            if (ch + 1 >= nchunk) break;
            SA_GATHER(rawA, ch + 2);
            SA_CHUNK(rawB, ch + 1);
        }
#undef SA_GATHER
#undef SA_CHUNK
#undef SA_CVT
        float lt = l_run; lt += __shfl_xor(lt, 16); lt += __shfl_xor(lt, 32);
        const float inv = (1.0f / CKV_S) / lt;
        if (head < 8) {
            bf16* op = olat + (size_t)qi * 2048 + head * 256 + 4 * g;
#pragma unroll
            for (int c = 0; c < 16; ++c) { const f32x4 o = oacc[c] * inv; *(u32x2*)(op + 16 * c) = (u32x2){pk2(o[0], o[1]), pk2(o[2], o[3])}; }
        }
    }
}

__global__ void __launch_bounds__(NTHREADS, 2) fwd_kernel(Args a) {
    extern __shared__ __attribute__((aligned(16))) unsigned char lds_raw[];
    lds_t* lds = (lds_t*)lds_raw;
    volatile LAS unsigned* MISC = (volatile LAS unsigned*)(lds + MISC_OFF);
    int tid = threadIdx.x, lane = tid & 63; const int wave = __builtin_amdgcn_readfirstlane(tid >> 6);
    const int G = gridDim.x, bx = blockIdx.x;
    const int gw = bx * NWAVES + wave, NGW = G * NWAVES;
    unsigned char* ws = a.ws;
    unsigned* ctl = (unsigned*)(ws + WS_CTL);
    if (tid < 64) MISC[tid] = 0u;
    __syncthreads();
    XcdBarrier bar; bar.bar = ctl + CW_BAR; bar.x = 0; bar.st = nullptr;
    if (a.use_bar) bar = xcd_barrier_post(ctl + CW_BAR, MISC + 8);
    const int lo = a.ph_lo, hi = a.ph_hi;
#ifndef PH_MASK
#define PH_MASK 0xFFFF
#endif
#define IN(k) (((PH_MASK >> (k)) & 1) && lo <= (k) && (k) < hi)
#define SEAM(k) do { if (IN(k) && IN((k) + 1)) xcd_barrier(bar); asm volatile("" : "+v"(tid)); lane = tid & 63; } while (0)

#define w_inT ((bf16*)(ws + WS_WIN_T))
#define w_outT ((bf16*)(ws + WS_WOUT_T))
#define w_cqT ((bf16*)(ws + WS_WCQ_T))
#define w_ckvT ((bf16*)(ws + WS_WCKV_T))
#define w_coT ((bf16*)(ws + WS_WCO_T))
#define w_ukb ((bf16*)(ws + WS_WUK))
#define w_uvP ((bf16*)(ws + WS_WUVP))
#define w_gu8 (ws + WS_WGU_T)
#define w_d8 (ws + WS_WD_T)
#define hn ((bf16*)(ws + WS_HN))
#define memn ((bf16*)(ws + WS_MEMN))
#define kvc ((bf16*)(ws + WS_KVC))
#define qc ((bf16*)(ws + WS_QC))
#define oc ((bf16*)(ws + WS_OC))
#define proj ((bf16*)(ws + X_PROJ))
#define qlat ((bf16*)(ws + X_QLAT))
#define sel ((int*)(ws + X_SEL))
#define nsel ((int*)(ws + X_NSEL))
#define kvbuf ((float*)(ws + X_KV))
#define rprev ((bf16*)(ws + X_RPREV))
#define mix ((bf16*)(ws + X_MIX))
#define rope ((float*)(ws + X_ROPE))
#define olat ((bf16*)(ws + X_OLAT))
#define kfrag ((unsigned char*)(ws + X_KFRAG))
#define ckv8 (ws + X_CKV8)
#define hres ((bf16*)(ws + WS_HRES))
#define asort (ws + X_ASORT)
#define hmid (ws + X_HMID)
#define ybuf ((bf16*)(ws + X_Y))
#define tok_e ((int*)(ws + R_TOKE))
#define tok_pos ((int*)(ws + R_TOKPOS))
#define tok_gate ((float*)(ws + R_TOKGATE))
#define tok_slot ((int*)(ws + R_TOKSLOT))
#define slot_gate ((float*)(ws + R_SLOTGATE))
#define slot_tok ((int*)(ws + R_SLOTTOK))
#define slot_rstd ((float*)(ws + WS_SLOTRSTD))
#define ssq2 ((const float*)(ws + WS_SSQ2))
    const bool cvt_in_idx = (G == 256);
    if (IN(0)) {
        LAS float* scr = (LAS float*)(lds + wave * 16896);
        for (int it = gw; it < 32 * (NPROJ / 32); it += NGW) { const int kb = it / (NPROJ / 32), nb = it % (NPROJ / 32);
            transpose_item(a.w_in, IN_WIDTH, w_inT, DM, 64 * kb, 32 * nb, scr, lane, [](int n) { return n < 2384 ? n : (n < 2560 ? -1 : n - 176); }); }
        for (int it = gw; it < 32 * 64; it += NGW) { const int kb = it / 64, nb = it % 64; transpose_item(a.w_out, DM, w_outT, DM, 64 * kb, 32 * nb, scr, lane, [](int n) { return n; }); }
        for (int it = gw; it < 32 * 16; it += NGW) { const int kb = it / 16, nb = it % 16; transpose_item(a.w_cq, 512, w_cqT, DM, 64 * kb, 32 * nb, scr, lane, [](int n) { return n; }, a.norm_cross); }
        for (int it = gw; it < 32 * 16; it += NGW) { const int kb = it / 16, nb = it % 16; transpose_item(a.w_ck, 512, w_ckvT, DM, 64 * kb, 32 * nb, scr, lane, [](int n) { return n; }); }
        for (int it = gw; it < 32 * 16; it += NGW) { const int kb = it / 16, nb = it % 16; transpose_item(a.w_cv, 512, w_ckvT + (size_t)512 * DM, DM, 64 * kb, 32 * nb, scr, lane, [](int n) { return n; }); }
        for (int it = gw; it < 8 * 64; it += NGW) { const int kb = it / 64, nb = it % 64; transpose_item(a.w_co, DM, w_coT, 512, 64 * kb, 32 * nb, scr, lane, [](int n) { return n; }); }
        for (int it = gw; it < 4 * 8 * 8; it += NGW) { const int p = it >> 6, kb = (it >> 3) & 7, nb = it & 7;
            const int nhalf = nb >> 2, khalf = kb >> 2;
            const int head = 2 * p + nhalf; const bool nz = (nhalf == khalf);
            transpose_item(a.w_uv + (size_t)(64 * (kb & 3)) * 1024, 1024, w_uvP + (size_t)p * 256 * 512 + 64 * kb, 512, 0, 32 * nb, scr, lane,
                           [=](int n) { return nz ? head * 128 + (n & 127) : -1; }); }
        for (int i = gw * 64 + lane; i < 2048 * 256 / 4; i += NGW * 64) { const int row = i >> 6, k4 = (i & 63) * 4, h = row >> 8, c = row & 255;
            f32x4 v = (f32x4){0.f, 0.f, 0.f, 0.f}; if ((k4 >> 7) == (h & 1)) v = *(const f32x4*)(a.w_uk + (size_t)c * 1024 + h * 128 + (k4 & 127));
            ((u32x2*)w_ukb)[i] = (u32x2){pk2(v.x, v.y), pk2(v.z, v.w)}; }
        if (!cvt_in_idx) { LAS float* scr8 = (LAS float*)(lds + wave * 16896);
          auto gu_map = [](int n) { return ((n & 255) < 128) ? 128 * (n >> 8) + (n & 127) : DFF + 128 * (n >> 8) + (n & 127); };
          auto id_map = [](int n) { return n; };
          constexpr int N_GU = NE * 2048, N_DN = NE * 1024;
#define T8_LOAD(V, it_) do { const int itc_ = (it_) < N_GU + N_DN ? (it_) : N_GU + N_DN - 1; \
              if (itc_ < N_GU) { const int e_ = itc_ >> 11, r_ = itc_ & 2047; t8_load(V, a.w_gu + (size_t)e_ * DM * 2 * DFF, 2 * DFF, 128 * (r_ >> 7), 32 * (r_ & 127), lane, gu_map); } \
              else { const int i2_ = itc_ - N_GU, e_ = i2_ >> 10, r_ = i2_ & 1023; t8_load(V, a.w_down + (size_t)e_ * DFF * DM, DM, 128 * (r_ >> 6), 32 * (r_ & 63), lane, id_map); } } while (0)
#define T8_FIN(V, it_) do { if ((it_) < N_GU) { const int e_ = (it_) >> 11, r_ = (it_) & 2047; t8_finish(V, w_gu8 + (size_t)e_ * 2 * DFF * DM, DM, 128 * (r_ >> 7), 32 * (r_ & 127), scr8, lane, FP8_WS); } \
              else { const int i2_ = (it_) - N_GU, e_ = i2_ >> 10, r_ = i2_ & 1023; t8_finish(V, w_d8 + (size_t)e_ * DM * DFF, DFF, 128 * (r_ >> 6), 32 * (r_ & 63), scr8, lane, FP8_WS); } } while (0)
          f32x4 va[16], vb[16];
          int it = gw;
          if (it < N_GU + N_DN) T8_LOAD(va, it);
          while (it < N_GU + N_DN) {
              T8_LOAD(vb, it + NGW); T8_FIN(va, it); it += NGW;
              if (it >= N_GU + N_DN) break;
              T8_LOAD(va, it + NGW); T8_FIN(vb, it); it += NGW;
          }
#undef T8_LOAD
#undef T8_FIN
        }
        for (int m = gw; m < T; m += NGW) rms_row_bf16(a.x + (size_t)m * DM, a.norm_mix, hn + (size_t)m * DM, lane);
        for (int m = gw; m < BATCH * NMEM; m += NGW) rms_row_bf16(a.mem + (size_t)m * DM, a.norm_mem, memn + (size_t)m * DM, lane);
        for (int i = gw * 64 + lane; i < T * 64; i += NGW * 64) { const int t = i >> 6, f = i & 63;
            const float inv = powf(10000.0f, -(float)(2 * f) / 128.0f); const float ang = (float)a.positions[t] * inv; float sn, cs; sincosf(ang, &sn, &cs);
            ((f32x2*)rope)[i] = (f32x2){cs, sn}; }
    }
    SEAM(0);

    if (IN(1)) {
        { pg8::DenseSched S; S.a_sh = 0; S.r_pm = 0; S.r_pn = 0; S.nM = T / 256; S.nN = NPROJ / 256; S.nwg = S.nM * S.nN; S.G = G; S.c = bx;
          S.A0 = (const char*)hn; S.B0 = (const char*)w_inT; S.C0 = (char*)proj; S.R0 = nullptr;
          S.a_pm = 256L * DM * 2; S.a_pn = 0; S.b_pn = 256L * DM * 2; S.c_pm = 256L * NPROJ * 2; S.c_pn = 512;
          pg8::EpiBf16S E{NPROJ, 1.0f};
          pg8::gemm_phase<pg8::EpiBf16S, pg8::DenseSched, true>(lds, DM, DM, DM, S, E); }
    }
    SEAM(1);

    if (IN(2)) {
        const int nkv = (G > 32) ? 16 : 0;
        if (bx < 16 || nkv == 0) { pg8::DenseSched S; S.a_sh = 0; S.r_pm = 0; S.r_pn = 0; S.nM = 4; S.nN = 4; S.nwg = 16; S.G = G; S.c = bx;
          S.A0 = (const char*)memn; S.B0 = (const char*)w_ckvT; S.C0 = (char*)kvc; S.R0 = nullptr;
          S.a_pm = 256L * DM * 2; S.a_pn = 0; S.b_pn = 256L * DM * 2; S.c_pm = 256L * 1024 * 2; S.c_pn = 512;
          pg8::EpiBf16S E{1024, 1.0f};
          pg8::gemm_phase<pg8::EpiBf16S, pg8::DenseSched, true>(lds, DM, DM, DM, S, E); }
        if (bx >= nkv)
        for (int m = (bx - nkv) * NWAVES + wave; m < T; m += (G - nkv) * NWAVES) {
            bf16* row = proj + (size_t)m * NPROJ;
            { u32x2 w = *((const u32x2*)(row + C_CKV) + lane); float v0 = bflo(w.x), v1 = bfhi(w.x), v2 = bflo(w.y), v3 = bfhi(w.y);
              const float rstd = rsqrtf(wave_sum(v0 * v0 + v1 * v1 + v2 * v2 + v3 * v3) * (1.f / 256.f) + EPS); const f32x4 g = ((const f32x4*)a.kv_norm)[lane];
              *((unsigned*)(ckv8 + (size_t)m * 256) + lane) = pk4_fp8(v0 * rstd * g.x * CKV_S, v1 * rstd * g.y * CKV_S, v2 * rstd * g.z * CKV_S, v3 * rstd * g.w * CKV_S); }
            { const float v = bf2f(row[C_KIDX + lane]); const float rstd = rsqrtf(wave_sum(v * v) * (1.f / 64.f) + EPS);
              const int bb = m >> 13, key = m & 8191, d = lane;
              const float kv = __builtin_amdgcn_fmed3f(v * rstd * a.idx_k_norm[lane] * IDX_KS, -448.0f, 448.0f);
              kfrag[((((size_t)(bb * 256 + (key >> 5)) * 2 + ((d >> 4) & 1)) * 64) + (d >> 5) * 32 + (key & 31)) * 16 + (d & 15)] = (unsigned char)(__builtin_amdgcn_cvt_pk_fp8_f32(kv, kv, 0, false) & 0xff); }
        }
    }
    SEAM(2);

    if (IN(3)) {
        { pg8::DenseSched S; S.a_sh = 0; S.r_pm = 0; S.r_pn = 0; S.nM = T / 256; S.nN = 8; S.nwg = S.nM * 8; S.G = G; S.c = bx;
          S.A0 = (const char*)(proj + C_QATT); S.B0 = (const char*)w_ukb; S.C0 = (char*)qlat; S.R0 = nullptr; S.a_sh = 1;
          S.a_pm = 256L * NPROJ * 2; S.a_pn = 512; S.b_pn = 256L * 256 * 2; S.c_pm = 256L * 2048 * 2; S.c_pn = 512;
          pg8::EpiBf16S E{2048, 0.08838834764831845f};
          pg8::gemm_phase<pg8::EpiBf16S, pg8::DenseSched, true>(lds, 256, NPROJ, 256, S, E); }
        __syncthreads();
        idx_phase(proj, kfrag, sel, nsel, lds, tid, lane, wave, bx, G, cvt_in_idx, a.w_gu, a.w_down, w_gu8, w_d8);
#if defined(PROBE_IDX2)
        __syncthreads(); idx_phase(proj, kfrag, sel, nsel, lds, tid, lane, wave, bx, G, cvt_in_idx, a.w_gu, a.w_down, w_gu8, w_d8);
#endif
        __syncthreads();
        {
            lds_t* kimg = lds;
            lds_t* vimg = lds + 32768;
            DECL_TRB(trb);
            unsigned trv[2][2];
#pragma unroll
            for (int i = 0; i < 2; ++i)
#pragma unroll
                for (int t = 0; t < 2; ++t) trv[i][t] = tr_addr16(lane, 0, (2 * wave + i) & 7, t) + (unsigned)((2 * wave + i) >> 3) * 32768u;
            for (int u = bx; u < 1024; u += G) {
                const int b = u >> 8, h = (u >> 6) & 3, c = u & 63; const int row0 = b * SEQ + c * 128;
                const float lg2 = log2f(1.0f - exp2f(-5.0f - (float)h));
                for (int it = tid; it < 1024; it += NTHREADS) { const int j = it >> 3, i0 = (it & 7) * 8;
                    const bf16* kp = proj + (size_t)(row0 + j) * NPROJ + C_KRET + h * 128 + i0;
                    const u32x4 x1 = *(const u32x4*)kp, x2 = *(const u32x4*)(kp + 64);
                    const float sc = 0.08838834764831845f * exp2f(lg2 * (float)(127 - j));
                    const f32x4* rp = (const f32x4*)(rope + ((size_t)(row0 + j) * 64 + i0) * 2);
                    const unsigned xa[4] = {x1.x, x1.y, x1.z, x1.w}, xb[4] = {x2.x, x2.y, x2.z, x2.w}; unsigned o1[4], o2[4];
#pragma unroll
                    for (int p = 0; p < 4; ++p) { const f32x4 cs = rp[p];
                        const float a0 = bflo(xa[p]), a1 = bfhi(xa[p]), b0 = bflo(xb[p]), b1 = bfhi(xb[p]);
                        o1[p] = pk2((a0 * cs.x - b0 * cs.y) * sc, (a1 * cs.z - b1 * cs.w) * sc); o2[p] = pk2((a0 * cs.y + b0 * cs.x) * sc, (a1 * cs.w + b1 * cs.z) * sc); }
                    *(LAS u32x4*)(kimg + off_b(j, i0 >> 3)) = (u32x4){o1[0], o1[1], o1[2], o1[3]};
                    *(LAS u32x4*)(kimg + off_b(j, 8 + (i0 >> 3))) = (u32x4){o2[0], o2[1], o2[2], o2[3]}; }
                { const char* vb = (const char*)(proj + (size_t)row0 * NPROJ + C_VRET + h * 256);
#pragma unroll
                  for (int i = 0; i < 8; ++i) { const int n = wave * 8 + i; const int j = 4 * (n & 31) + (lane >> 4), ch = (lane & 15) ^ ((((lane >> 4) & 3) << 2) | (n & 3));
                      __builtin_amdgcn_global_load_lds((const unsigned*)(vb + (size_t)j * (NPROJ * 2) + (n >> 5) * 256 + ch * 16), (LAS unsigned*)(vimg + (n >> 5) * 32768 + (n & 31) * 1024), 16, 0, 0); } }
                asm volatile("s_waitcnt vmcnt(0)" ::: "memory");
                __syncthreads();
                f32x4 acc[2][8];
#pragma unroll
                for (int i = 0; i < 2; ++i)
#pragma unroll
                    for (int d = 0; d < 8; ++d) acc[i][d] = (f32x4){0.f, 0.f, 0.f, 0.f};
#pragma unroll
                for (int ks = 0; ks < 4; ++ks) {
                    bf16x8 Av[2], Bk[8];
#pragma unroll
                    for (int i = 0; i < 2; ++i) Av[i] = cat4(tr_read(vimg + trv[i][0] + 8192 * ks), tr_read(vimg + trv[i][1] + 8192 * ks));
#pragma unroll
                    for (int d = 0; d < 8; ++d) Bk[d] = cat4(tr_read(kimg + trb[0][d] + 8192 * ks), tr_read(kimg + trb[1][d] + 8192 * ks));
#pragma unroll
                    for (int i = 0; i < 2; ++i)
#pragma unroll
                        for (int d = 0; d < 8; ++d) acc[i][d] = __builtin_amdgcn_mfma_f32_16x16x32_bf16(Av[i], Bk[d], acc[i][d], 0, 0, 0);
                }
                float* kvo = kvbuf + (size_t)u * 32768;
#pragma unroll
                for (int i = 0; i < 2; ++i)
#pragma unroll
                    for (int d = 0; d < 8; ++d)
#pragma unroll
                        for (int r = 0; r < 4; ++r) kvo[(size_t)(16 * (2 * wave + i) + 4 * (lane >> 4) + r) * 128 + 16 * d + (lane & 15)] = acc[i][d][r];
                __syncthreads();
            }
        }
    }
    SEAM(3);

    if (IN(4)) {
        for (int i = bx * NTHREADS + tid; i < 16 * 32768; i += G * NTHREADS) {
            const int bh = i >> 15, ed = i & 32767, h = bh & 3;
            const float cd = exp2f(128.0f * log2f(1.0f - exp2f(-5.0f - (float)h)));
            float R = 0.f;
            const float* src = kvbuf + (size_t)bh * 64 * 32768 + ed; bf16* dst = rprev + (size_t)bh * 64 * 32768 + ed;
            for (int c0 = 0; c0 < 64; c0 += 8) { float kv[8];
#pragma unroll
                for (int c = 0; c < 8; ++c) kv[c] = src[(size_t)(c0 + c) * 32768];
#pragma unroll
                for (int c = 0; c < 8; ++c) { dst[(size_t)(c0 + c) * 32768] = (bf16)f2bf(R); R = R * cd + kv[c]; } }
        }
        __syncthreads();
        sattn_phase(ckv8, qlat, olat, sel, nsel, a.positions, a.rel_bias, lds, tid, lane, wave, gw, NGW);
#if defined(PROBE_ATT2)
        __syncthreads(); sattn_phase(ckv8, qlat, olat, sel, nsel, a.positions, a.rel_bias, lds, tid, lane, wave, gw, NGW);
#endif
    }
    SEAM(4);

    if (IN(5)) {
        { pg8::DenseSched S; S.a_sh = 0; S.r_pm = 0; S.r_pn = 0; S.nM = T / 256; S.nN = 4; S.nwg = S.nM * 4; S.G = G; S.c = bx;
          S.A0 = (const char*)olat; S.B0 = (const char*)w_uvP; S.C0 = (char*)mix; S.R0 = nullptr;
          S.a_pm = 256L * 2048 * 2; S.a_pn = 1024; S.b_pn = 256L * 512 * 2; S.c_pm = 256L * 2048 * 2; S.c_pn = 512;
          pg8::EpiBf16S E{2048, 1.0f};
          pg8::gemm_phase<pg8::EpiBf16S, pg8::DenseSched, true>(lds, 512, 2048, 512, S, E); }
        __syncthreads();
        {
            lds_t* kimg = lds + 32768; lds_t* vimg = lds + 65536;
            const unsigned keep8 = MISC[8], keep9 = MISC[9];
            __syncthreads();
            const int g = lane >> 4, m15 = lane & 15;
            DECL_AROW(arow); DECL_TRB(trb);
            unsigned rtoff[4];
#pragma unroll
            for (int s = 0; s < 4; ++s) rtoff[s] = off_b((unsigned)m15, 4u * s + (unsigned)g);
            for (int u = bx; u < 1024; u += G) {
                const int b = u >> 8, h = (u >> 6) & 3, c = u & 63; const int row0 = b * SEQ + c * 128;
                const float lg2 = log2f(1.0f - exp2f(-5.0f - (float)h));
                { const char* Rt = (const char*)(rprev + (size_t)u * 32768);
#pragma unroll
                  for (int i = 0; i < 8; ++i) { const int n = wave * 8 + i; const int r = 4 * n + (lane >> 4), ch = (lane & 15) ^ ((((lane >> 4) & 3) << 2) | (n & 3));
                      __builtin_amdgcn_global_load_lds((const unsigned*)(Rt + r * 256 + ch * 16), (LAS unsigned*)((n < 32 ? lds : lds + 131072 - 32768) + n * 1024), 16, 0, 0); } }
                const int il = 16 * wave + m15;
                bf16x8 Qf[4];
                { const bf16* qp = proj + (size_t)(row0 + il) * NPROJ + C_QRET + h * 128 + 8 * g; const float* rp0 = rope + ((size_t)(row0 + il) * 64 + 8 * g) * 2;
#pragma unroll
                  for (int s = 0; s < 2; ++s) { const u32x4 x1 = *(const u32x4*)(qp + 32 * s), x2 = *(const u32x4*)(qp + 32 * s + 64); const f32x4* rp = (const f32x4*)(rp0 + 64 * s);
                      const unsigned xa[4] = {x1.x, x1.y, x1.z, x1.w}, xb[4] = {x2.x, x2.y, x2.z, x2.w}; unsigned o1[4], o2[4];
#pragma unroll
                      for (int p = 0; p < 4; ++p) { const f32x4 cs = rp[p];
                          const float a0 = bflo(xa[p]), a1 = bfhi(xa[p]), b0 = bflo(xb[p]), b1 = bfhi(xb[p]);
                          o1[p] = pk2(a0 * cs.x - b0 * cs.y, a1 * cs.z - b1 * cs.w); o2[p] = pk2(a0 * cs.y + b0 * cs.x, a1 * cs.w + b1 * cs.z); }
                      Qf[s] = __builtin_bit_cast(bf16x8, (u32x4){o1[0], o1[1], o1[2], o1[3]}); Qf[s + 2] = __builtin_bit_cast(bf16x8, (u32x4){o2[0], o2[1], o2[2], o2[3]}); } }
                for (int it = tid; it < 1024; it += NTHREADS) { const int j = (it >> 3) & 127, i0 = (it & 7) * 8;
                    const bf16* kp = proj + (size_t)(row0 + j) * NPROJ + C_KRET + h * 128 + i0;
                    const u32x4 x1 = *(const u32x4*)kp, x2 = *(const u32x4*)(kp + 64);
                    const float sc = 0.08838834764831845f;
                    const f32x4* rp = (const f32x4*)(rope + ((size_t)(row0 + j) * 64 + i0) * 2);
                    const unsigned xa[4] = {x1.x, x1.y, x1.z, x1.w}, xb[4] = {x2.x, x2.y, x2.z, x2.w}; unsigned o1[4], o2[4];
#pragma unroll
                    for (int p = 0; p < 4; ++p) { const f32x4 cs = rp[p];
                        const float a0 = bflo(xa[p]), a1 = bfhi(xa[p]), b0 = bflo(xb[p]), b1 = bfhi(xb[p]);
                        o1[p] = pk2((a0 * cs.x - b0 * cs.y) * sc, (a1 * cs.z - b1 * cs.w) * sc); o2[p] = pk2((a0 * cs.y + b0 * cs.x) * sc, (a1 * cs.w + b1 * cs.z) * sc); }
                    *(LAS u32x4*)(kimg + off_b(j, i0 >> 3)) = (u32x4){o1[0], o1[1], o1[2], o1[3]};
                    *(LAS u32x4*)(kimg + off_b(j, 8 + (i0 >> 3))) = (u32x4){o2[0], o2[1], o2[2], o2[3]}; }
                { const char* vb = (const char*)(proj + (size_t)row0 * NPROJ + C_VRET + h * 256);
#pragma unroll
                  for (int i = 0; i < 8; ++i) { const int n = wave * 8 + i; const int j = 4 * (n & 31) + (lane >> 4), ch = (lane & 15) ^ ((((lane >> 4) & 3) << 2) | (n & 3));
                      __builtin_amdgcn_global_load_lds((const unsigned*)(vb + (size_t)j * (NPROJ * 2) + (n >> 5) * 256 + ch * 16), (LAS unsigned*)(vimg + (n >> 5) * 32768 + (n & 31) * 1024), 16, 0, 0); } }
                asm volatile("s_waitcnt vmcnt(0)" ::: "memory");
                __syncthreads();
                f32x4 oacc[16];
#pragma unroll
                for (int cc = 0; cc < 16; ++cc) oacc[cc] = (f32x4){0.f, 0.f, 0.f, 0.f};
#pragma unroll
                for (int s = 0; s < 4; ++s) { bf16x8 Ar[16];
#pragma unroll
                    for (int cc = 0; cc < 16; ++cc) Ar[cc] = *(const LAS bf16x8*)((cc < 8 ? lds : lds + 131072 - 32768) + 4096 * cc + rtoff[s]);
#pragma unroll
                    for (int cc = 0; cc < 16; ++cc) oacc[cc] = __builtin_amdgcn_mfma_f32_16x16x32_bf16(Ar[cc], Qf[s], oacc[cc], 0, 0, 0);
                    __builtin_amdgcn_sched_barrier(0); }
                const float cdec = exp2f(lg2 * (float)(il + 1));
#pragma unroll
                for (int cc = 0; cc < 16; ++cc) oacc[cc] = oacc[cc] * cdec;
                const bf16* gp = proj + (size_t)(row0 + il) * NPROJ + C_GRET + h * 256 + 4 * g;
                u32x2 gwv[16];
#pragma unroll
                for (int cc = 0; cc < 16; ++cc) gwv[cc] = *(const u32x2*)(gp + 16 * cc);
#pragma unroll 1
                for (int jc = 0; jc <= (wave >> 1); ++jc) {
                    f32x4 sc2[2];
#pragma unroll
                    for (int rb = 0; rb < 2; ++rb) { sc2[rb] = (f32x4){0.f, 0.f, 0.f, 0.f};
#pragma unroll
                        for (int s = 0; s < 4; ++s) { const bf16x8 A = *(const LAS bf16x8*)(kimg + 8192 * jc + arow[rb][s]);
                            sc2[rb] = __builtin_amdgcn_mfma_f32_16x16x32_bf16(A, Qf[s], sc2[rb], 0, 0, 0); } }
                    float p[8];
#pragma unroll
                    for (int rb = 0; rb < 2; ++rb)
#pragma unroll
                        for (int r = 0; r < 4; ++r) { const int j = 32 * jc + 8 * g + 4 * rb + r; const int dd = il - j; p[4 * rb + r] = (dd >= 0) ? sc2[rb][r] * exp2f(lg2 * (float)(dd > 0 ? dd : 0)) : 0.f; }
                    const u32x4 pw = (u32x4){pk2(p[0], p[1]), pk2(p[2], p[3]), pk2(p[4], p[5]), pk2(p[6], p[7])};
                    const bf16x8 Pf = __builtin_bit_cast(bf16x8, pw);
#pragma unroll
                    for (int cc = 0; cc < 16; ++cc) { const lds_t* im = vimg + (cc >> 3) * 32768 + 8192 * jc;
                        const bf16x8 A = cat4(tr_read(im + trb[0][cc & 7]), tr_read(im + trb[1][cc & 7]));
                        oacc[cc] = __builtin_amdgcn_mfma_f32_16x16x32_bf16(A, Pf, oacc[cc], 0, 0, 0); }
                }
                float ss = 0.f;
#pragma unroll
                for (int cc = 0; cc < 16; ++cc) ss += (oacc[cc][0] * oacc[cc][0] + oacc[cc][1] * oacc[cc][1]) + (oacc[cc][2] * oacc[cc][2] + oacc[cc][3] * oacc[cc][3]);
                ss += __shfl_xor(ss, 16); ss += __shfl_xor(ss, 32);
                const float rstd = rsqrtf(ss * (1.f / 256.f) + EPS);
                bf16* op = mix + (size_t)(row0 + il) * 2048 + 1024 + h * 256 + 4 * g;
#pragma unroll
                for (int cc = 0; cc < 16; ++cc) { const u32x2 gw2 = gwv[cc]; const float gv[4] = {bflo(gw2.x), bfhi(gw2.x), bflo(gw2.y), bfhi(gw2.y)}; float o[4];
#pragma unroll
                    for (int r = 0; r < 4; ++r) { const float sg = gv[r] * __builtin_amdgcn_rcpf(1.0f + __builtin_amdgcn_exp2f(-LOG2E * gv[r])); o[r] = sg * oacc[cc][r] * rstd; }
                    *(u32x2*)(op + 16 * cc) = (u32x2){pk2(o[0], o[1]), pk2(o[2], o[3])}; }
                __syncthreads();
            }
            if (tid == 0) { MISC[8] = keep8; MISC[9] = keep9; }
        }
    }
    SEAM(5);

    if (IN(6)) {
        pg8::DenseSched S; S.a_sh = 0; S.r_pm = 0; S.r_pn = 0; S.nM = T / 256; S.nN = 8; S.nwg = S.nM * 8; S.G = G; S.c = bx;
        S.A0 = (const char*)mix; S.B0 = (const char*)w_outT; S.C0 = (char*)hres; S.R0 = (const char*)a.x;
        S.a_pm = 256L * 2048 * 2; S.a_pn = 0; S.b_pn = 256L * 2048 * 2; S.c_pm = 256L * DM * 2; S.c_pn = 512; S.r_pm = 256L * DM * 4; S.r_pn = 1024;
        pg8::EpiResBf16 E{DM, DM, true, nullptr, nullptr, (float*)(ws + WS_SSQ1), (LAS float*)(lds + MOE_TAB_OFF)};
        pg8::gemm_phase<pg8::EpiResBf16, pg8::DenseSched, true>(lds, 2048, 2048, 2048, S, E);
    }
    SEAM(6);


    if (IN(8)) {
        pg8::DenseSched S; S.a_sh = 0; S.r_pm = 0; S.r_pn = 0; S.nM = T / 256; S.nN = 2; S.nwg = S.nM * 2; S.G = G; S.c = bx;
        S.A0 = (const char*)hres; S.B0 = (const char*)w_cqT; S.C0 = (char*)qc; S.R0 = nullptr;
        S.a_pm = 256L * DM * 2; S.a_pn = 0; S.b_pn = 256L * DM * 2; S.c_pm = 256L * 512 * 2; S.c_pn = 512;
        pg8::EpiBf16RS E{512, (const float*)(ws + WS_SSQ1)};
        pg8::gemm_phase<pg8::EpiBf16RS, pg8::DenseSched, true>(lds, DM, DM, DM, S, E);
    }
    SEAM(8);

    if (IN(9)) {
        lds_t* kimg = lds; lds_t* vimg = lds + 65536;
        const int g = lane >> 4, m15 = lane & 15;
        DECL_AROW(arow); DECL_TRB(trb);
        for (int it = bx; it < 256; it += G) {
            const int b = it >> 6, hd = (it >> 4) & 3, slab = it & 15;
            for (int i2 = tid; i2 < 8192; i2 += NTHREADS) { const int which = i2 >> 12, key = (i2 >> 4) & 255, ch = i2 & 15;
                const u32x4 v = *(const u32x4*)(kvc + (size_t)(b * NMEM + key) * 1024 + which * 512 + hd * 128 + ch * 8);
                *(LAS u32x4*)((which ? vimg : kimg) + off_b(key, ch)) = v; }
            __syncthreads();
            bf16x8 Qf[4];
#pragma unroll
            for (int s = 0; s < 4; ++s) Qf[s] = *(const bf16x8*)(qc + (size_t)(b * SEQ + slab * 512 + wave * 16 + m15) * 512 + hd * 128 + 32 * s + 8 * g);
            for (int qt = wave; qt < 32; qt += NWAVES) {
                const int tq = b * SEQ + slab * 512 + qt * 16 + m15;
                f32x4 sc[16];
#pragma unroll
                for (int kb = 0; kb < 16; ++kb) { sc[kb] = (f32x4){0.f, 0.f, 0.f, 0.f};
#pragma unroll
                    for (int s = 0; s < 4; ++s) { const bf16x8 A = *(const LAS bf16x8*)(kimg + 8192 * (kb >> 1) + arow[kb & 1][s]);
                        sc[kb] = __builtin_amdgcn_mfma_f32_16x16x32_bf16(A, Qf[s], sc[kb], 0, 0, 0); }
                    if (kb & 1) __builtin_amdgcn_sched_barrier(0); }
                float mxv = -INFINITY;
                const float scl = 0.08838834764831845f * LOG2E;
#pragma unroll
                for (int kb = 0; kb < 16; ++kb)
#pragma unroll
                    for (int r = 0; r < 4; ++r) { sc[kb][r] *= scl; mxv = fmaxf(mxv, sc[kb][r]); }
                mxv = fmaxf(mxv, __shfl_xor(mxv, 16)); mxv = fmaxf(mxv, __shfl_xor(mxv, 32));
                float ls = 0.f;
#pragma unroll
                for (int kb = 0; kb < 16; ++kb)
#pragma unroll
                    for (int r = 0; r < 4; ++r) { sc[kb][r] = __builtin_amdgcn_exp2f(sc[kb][r] - mxv); ls += sc[kb][r]; }
                ls += __shfl_xor(ls, 16); ls += __shfl_xor(ls, 32);
                f32x4 oacc[8];
#pragma unroll
                for (int cc = 0; cc < 8; ++cc) oacc[cc] = (f32x4){0.f, 0.f, 0.f, 0.f};
#pragma unroll
                for (int kc = 0; kc < 8; ++kc) {
                    const u32x4 pw = (u32x4){pk2(sc[2 * kc][0], sc[2 * kc][1]), pk2(sc[2 * kc][2], sc[2 * kc][3]), pk2(sc[2 * kc + 1][0], sc[2 * kc + 1][1]), pk2(sc[2 * kc + 1][2], sc[2 * kc + 1][3])};
                    const bf16x8 Pf = __builtin_bit_cast(bf16x8, pw);
#pragma unroll
                    for (int cc = 0; cc < 8; ++cc) { const bf16x8 A = cat4(tr_read(vimg + 8192 * kc + trb[0][cc]), tr_read(vimg + 8192 * kc + trb[1][cc]));
                        oacc[cc] = __builtin_amdgcn_mfma_f32_16x16x32_bf16(A, Pf, oacc[cc], 0, 0, 0); }
                    __builtin_amdgcn_sched_barrier(0);
                }
                const float inv = 1.0f / ls;
                { const int qn = (qt + NWAVES < 32) ? qt + NWAVES : qt; const int tn = b * SEQ + slab * 512 + qn * 16 + m15;
#pragma unroll
                  for (int s = 0; s < 4; ++s) Qf[s] = *(const bf16x8*)(qc + (size_t)tn * 512 + hd * 128 + 32 * s + 8 * g); }
                __builtin_amdgcn_sched_barrier(0);
                bf16* op = oc + (size_t)tq * 512 + hd * 128 + 4 * g;
#pragma unroll
                for (int cc = 0; cc < 8; ++cc) { const f32x4 o = oacc[cc] * inv; *(u32x2*)(op + 16 * cc) = (u32x2){pk2(o[0], o[1]), pk2(o[2], o[3])}; }
            }
            __syncthreads();
        }
    }
    SEAM(9);

    if (IN(10)) {
        pg8::DenseSched S; S.a_sh = 0; S.r_pm = 0; S.r_pn = 0; S.nM = T / 256; S.nN = 8; S.nwg = S.nM * 8; S.G = G; S.c = bx;
        S.A0 = (const char*)oc; S.B0 = (const char*)w_coT; S.C0 = (char*)hres; S.R0 = (const char*)hres;
        S.a_pm = 256L * 512 * 2; S.a_pn = 0; S.b_pn = 256L * 512 * 2; S.c_pm = 256L * DM * 2; S.c_pn = 512; S.r_pm = 256L * DM * 2; S.r_pn = 512;
        pg8::EpiResBf16 E{DM, DM, false, asort, a.norm_ffn, (float*)(ws + WS_SSQ2), (LAS float*)(lds + MOE_TAB_OFF)};
        pg8::gemm_phase<pg8::EpiResBf16, pg8::DenseSched, true>(lds, 512, 512, 512, S, E);
    }
    SEAM(10);

    if (IN(11)) {
        LAS float* lt = (LAS float*)(lds + wave * 4608);
        for (int tile = (wave < 4) ? bx * 4 + wave : T / 32; tile < T / 32; tile += G * 4) {
            const int t0 = tile * 32; int l11 = lane; asm volatile("" : "+v"(l11));
            const int i = l11 & 31, kk = l11 >> 5;
            const bf16* hrow = hres + (size_t)(t0 + i) * DM + 4 * kk;
            f32x16 acc = {}; float ssq = 0.f;
            for (int m = 0; m < 256; ++m) {
                const u32x2 hw = *(const u32x2*)(hrow + 8 * m); const f32x4 hv = (f32x4){bflo(hw.x), bfhi(hw.x), bflo(hw.y), bfhi(hw.y)}; const f32x4 gv = *(const f32x4*)(a.norm_ffn + 8 * m + 4 * kk);
                ssq += (hv.x * hv.x + hv.y * hv.y) + (hv.z * hv.z + hv.w * hv.w);
                const float* wp = a.w_router + (size_t)(8 * m + 4 * kk) * NE + i;
                const float b0 = wp[0], b1 = wp[NE], b2 = wp[2 * NE], b3 = wp[3 * NE];
                acc = __builtin_amdgcn_mfma_f32_32x32x2f32(hv.x * gv.x, b0, acc, 0, 0, 0);
                acc = __builtin_amdgcn_mfma_f32_32x32x2f32(hv.y * gv.y, b1, acc, 0, 0, 0);
                acc = __builtin_amdgcn_mfma_f32_32x32x2f32(hv.z * gv.z, b2, acc, 0, 0, 0);
                acc = __builtin_amdgcn_mfma_f32_32x32x2f32(hv.w * gv.w, b3, acc, 0, 0, 0);
            }
            ssq += __shfl_xor(ssq, 32);
            const float rstd = rsqrtf(ssq * (1.f / DM) + EPS);
#pragma unroll
            for (int r = 0; r < 16; ++r) lt[((r & 3) + 8 * (r >> 2) + 4 * kk) * 33 + i] = acc[r];
            LDS_WAIT();
            int e_sel[4]; float v_sel[4];
            {
                float lv[32];
#pragma unroll
                for (int e = 0; e < 32; ++e) lv[e] = lt[i * 33 + e] * rstd + a.b_router[e];
#pragma unroll
                for (int k = 0; k < 4; ++k) { float best = -INFINITY; int be = 0;
#pragma unroll
                    for (int e = 0; e < 32; ++e) { const bool tk = lv[e] > best; best = tk ? lv[e] : best; be = tk ? e : be; }
                    e_sel[k] = be; v_sel[k] = best;
#pragma unroll
                    for (int e = 0; e < 32; ++e) lv[e] = (e == be) ? -INFINITY : lv[e]; }
            }
            LDS_WAIT();
            const float mxl = v_sel[0]; float ex[4], sm = 0.f;
#pragma unroll
            for (int k = 0; k < 4; ++k) { ex[k] = __expf(v_sel[k] - mxl); sm += ex[k]; }
            const float rs = 1.0f / sm;
            const unsigned long long ltmask = (1ull << lane) - 1ull;
#pragma unroll
            for (int k = 0; k < 4; ++k) {
                const int myE = (lane < 32) ? e_sel[k] : -1; int mypos = 0;
                for (int ee = 0; ee < NE; ++ee) { const unsigned long long mk = __ballot(myE == ee);
                    if (mk) { unsigned base = 0; if (lane == 0) base = __hip_atomic_fetch_add(ctl + CW_ECNT + 64 * ee, (unsigned)__builtin_popcountll(mk), __ATOMIC_RELAXED, __HIP_MEMORY_SCOPE_AGENT);
                        base = __builtin_amdgcn_readfirstlane(base); if (myE == ee) mypos = (int)(base + (unsigned)__builtin_popcountll(mk & ltmask)); } }
                if (lane < 32) { tok_e[(t0 + i) * 4 + k] = e_sel[k]; tok_pos[(t0 + i) * 4 + k] = mypos; tok_gate[(t0 + i) * 4 + k] = ex[k] * rs; }
            }
        }
    }
    SEAM(11);

    LAS int* moe_tab = (LAS int*)(lds + MOE_TAB_OFF);
    if (IN(12) || IN(13) || IN(14)) {
        if (tid == 0) { int acc_t = 0; for (int e = 0; e < NE; ++e) { const int cnt = (int)__hip_atomic_load(ctl + CW_ECNT + 64 * e, __ATOMIC_RELAXED, __HIP_MEMORY_SCOPE_AGENT); const int nt = (cnt + 255) >> 8;
                moe_tab[e] = acc_t * 256; for (int j = 0; j < nt; ++j) moe_tab[64 + acc_t + j] = e; acc_t += nt; } moe_tab[32] = acc_t; }
        __syncthreads();
    }
    if (IN(12)) {
        for (int e = gw; e < NE; e += NGW) { const int cnt = (int)__hip_atomic_load(ctl + CW_ECNT + 64 * e, __ATOMIC_RELAXED, __HIP_MEMORY_SCOPE_AGENT);
            const int s0 = moe_tab[e] + cnt, s1 = moe_tab[e] + ((cnt + 255) & ~255); for (int s = s0 + lane; s < s1; s += 64) { slot_tok[s] = 0; slot_rstd[s] = 0.f; } }
        for (int t = bx * NTHREADS + tid; t < T; t += G * NTHREADS) {
            const f32x4 p0 = *(const f32x4*)(ssq2 + (size_t)t * 8), p1 = *(const f32x4*)(ssq2 + (size_t)t * 8 + 4);
            const float rstd = rsqrtf((((p0[0] + p0[1]) + (p0[2] + p0[3])) + ((p1[0] + p1[1]) + (p1[2] + p1[3]))) * (1.f / DM) + EPS);
            const i32x4 te = *(const i32x4*)(tok_e + t * 4), tp = *(const i32x4*)(tok_pos + t * 4); const f32x4 tg = *(const f32x4*)(tok_gate + t * 4);
            i32x4 sl;
#pragma unroll
            for (int k = 0; k < 4; ++k) { const int s = moe_tab[te[k]] + tp[k]; sl[k] = s; slot_tok[s] = t; slot_rstd[s] = rstd; slot_gate[s] = tg[k]; }
            *(i32x4*)(tok_slot + t * 4) = sl;
        }
    }
    SEAM(12);

    if (IN(13)) {
        pg8::MoeSched S; S.NT = 16; S.nunits = __builtin_amdgcn_readfirstlane(moe_tab[32]) * 16; S.G = G; S.c = bx; S.tab = moe_tab + 64;
        S.A0 = (const char*)asort; S.B0 = (const char*)w_gu8; S.C0 = (char*)hmid; S.R0 = (const char*)slot_gate;
        S.rowmap = slot_tok; S.idxb = moe_tab + 1024;
        S.a_mt = 0; S.b_e = (long)2 * DFF * DM; S.b_pn = 256L * DM; S.c_mt = 256L * DFF; S.c_pn = 128; S.r_mt = 1024;
        pg8::EpiSwiglu E{a.b_gu, slot_rstd};
        pg8::gemm_phase<pg8::EpiSwiglu, pg8::MoeSched, true, true, true>(lds, DM / 2, DM / 2, DM / 2, S, E);
    }
    SEAM(13);

    if (IN(14)) {
        pg8::MoeSched S; S.NT = 8; S.nunits = __builtin_amdgcn_readfirstlane(moe_tab[32]) * 8; S.G = G; S.c = bx; S.tab = moe_tab + 64;
        S.A0 = (const char*)hmid; S.B0 = (const char*)w_d8; S.C0 = (char*)ybuf; S.R0 = (const char*)slot_gate;
        S.a_mt = 256L * DFF; S.b_e = (long)DM * DFF; S.b_pn = 256L * DFF; S.c_mt = 256L * DM; S.c_pn = 256; S.r_mt = 1024;
        pg8::EpiDown E{a.b_down};
        pg8::gemm_phase<pg8::EpiDown, pg8::MoeSched, true, true>(lds, DFF / 2, DFF / 2, DFF / 2, S, E);
    }
    SEAM(14);

    if (IN(15)) {
        for (int m = gw; m < T; m += NGW) {
            float* row = a.out + (size_t)m * DM;
            const u32x2* xr = (const u32x2*)(hres + (size_t)m * DM) + lane; const f32x4* gr = (const f32x4*)a.norm_final + lane;
            const int s0 = tok_slot[m * 4 + 0], s1 = tok_slot[m * 4 + 1], s2 = tok_slot[m * 4 + 2], s3 = tok_slot[m * 4 + 3];
            const unsigned char* yb = (const unsigned char*)ybuf;
            const unsigned* y0 = (const unsigned*)(yb + (size_t)s0 * DM) + lane; const unsigned* y1 = (const unsigned*)(yb + (size_t)s1 * DM) + lane;
            const unsigned* y2 = (const unsigned*)(yb + (size_t)s2 * DM) + lane; const unsigned* y3 = (const unsigned*)(yb + (size_t)s3 * DM) + lane;
            f32x4 v[8]; float s = 0.f;
#pragma unroll
            for (int j = 0; j < 8; ++j) { { const u32x2 hw = xr[64 * j]; v[j] = (f32x4){bflo(hw.x), bfhi(hw.x), bflo(hw.y), bfhi(hw.y)}; }
                const unsigned a0 = y0[64 * j], a1 = y1[64 * j], a2 = y2[64 * j], a3 = y3[64 * j];
                const f32x2 l0 = __builtin_amdgcn_cvt_pk_f32_fp8((int)a0, false), h0 = __builtin_amdgcn_cvt_pk_f32_fp8((int)a0, true), l1 = __builtin_amdgcn_cvt_pk_f32_fp8((int)a1, false), h1 = __builtin_amdgcn_cvt_pk_f32_fp8((int)a1, true);
                const f32x2 l2 = __builtin_amdgcn_cvt_pk_f32_fp8((int)a2, false), h2 = __builtin_amdgcn_cvt_pk_f32_fp8((int)a2, true), l3 = __builtin_amdgcn_cvt_pk_f32_fp8((int)a3, false), h3 = __builtin_amdgcn_cvt_pk_f32_fp8((int)a3, true);
                v[j].x += ((l0.x + l1.x) + (l2.x + l3.x)) * (1.0f / Y_S); v[j].y += ((l0.y + l1.y) + (l2.y + l3.y)) * (1.0f / Y_S);
                v[j].z += ((h0.x + h1.x) + (h2.x + h3.x)) * (1.0f / Y_S); v[j].w += ((h0.y + h1.y) + (h2.y + h3.y)) * (1.0f / Y_S);
                s += (v[j].x * v[j].x + v[j].y * v[j].y) + (v[j].z * v[j].z + v[j].w * v[j].w); }
            const float rstd = rsqrtf(wave_sum(s) * (1.f / DM) + EPS);
            f32x4* orow = (f32x4*)row + lane;
#pragma unroll
            for (int j = 0; j < 8; ++j) { const f32x4 g = gr[64 * j]; orow[64 * j] = (f32x4){v[j].x * rstd * g.x, v[j].y * rstd * g.y, v[j].z * rstd * g.z, v[j].w * rstd * g.w}; }
        }
    }
#undef w_inT
#undef w_outT
#undef w_cqT
#undef w_ckvT
#undef w_coT
#undef w_ukb
#undef w_uvP
#undef w_gu8
#undef w_d8
#undef hn
#undef memn
#undef kvc
#undef qc
#undef oc
#undef proj
#undef qlat
#undef sel
#undef nsel
#undef kvbuf
#undef rprev
#undef mix
#undef rope
#undef olat
#undef kfrag
#undef ckv8
#undef hres
#undef asort
#undef hmid
#undef ybuf
#undef tok_e
#undef tok_pos
#undef tok_gate
#undef tok_slot
#undef slot_gate
#undef slot_tok
#undef slot_rstd
#undef ssq2
#undef IN
#undef SEAM
}

constexpr int N_PHASES = 16;
#ifndef MK_ONE_LAUNCH
#define MK_ONE_LAUNCH 1
#endif
#ifndef REP_MASK
#define REP_MASK 0
#endif
extern "C" void kernel_launch(void* const* d_in, const int* in_sizes, int n_in, void* d_out, int out_size, void* d_ws, size_t ws_size, hipStream_t stream) {
    static int grid = 0;
    if (grid == 0) {
        if (n_in != 25 || out_size != T * DM || ws_size < WS_END) { fprintf(stderr, "kernel_launch: unexpected shapes: n_in %d out %d ws %zu (need %zu)\n", n_in, out_size, ws_size, (size_t)WS_END); grid = -1; return; }
        int dev = 0, cus = 0;
        if (hipGetDevice(&dev) != hipSuccess || hipDeviceGetAttribute(&cus, hipDeviceAttributeMultiprocessorCount, dev) != hipSuccess) { grid = -1; return; }
        if (hipFuncSetAttribute((const void*)fwd_kernel, hipFuncAttributeMaxDynamicSharedMemorySize, LDS_BYTES) != hipSuccess) { fprintf(stderr, "kernel_launch: hipFuncSetAttribute failed\n"); grid = -1; return; }
        int per_cu = 0;
        if (hipOccupancyMaxActiveBlocksPerMultiprocessor(&per_cu, (const void*)fwd_kernel, NTHREADS, LDS_BYTES) != hipSuccess || per_cu < 1) { fprintf(stderr, "kernel_launch: occupancy query says %d\n", per_cu); }
        (void)hipGetLastError();
        grid = cus;
    }
    if (grid < 0) return;
    (void)hipMemsetAsync((char*)d_ws + WS_CTL, 0, CTL_ZERO_BYTES, stream);
    Args a{};
    a.x = (const float*)d_in[0]; a.mem = (const float*)d_in[1]; a.positions = (const int*)d_in[2]; a.norm_mix = (const float*)d_in[3]; a.w_in = (const float*)d_in[4];
    a.kv_norm = (const float*)d_in[5]; a.idx_k_norm = (const float*)d_in[6]; a.w_uk = (const float*)d_in[7]; a.w_uv = (const float*)d_in[8]; a.rel_bias = (const float*)d_in[9];
    a.w_out = (const float*)d_in[10]; a.norm_cross = (const float*)d_in[11]; a.norm_mem = (const float*)d_in[12]; a.w_cq = (const float*)d_in[13]; a.w_ck = (const float*)d_in[14];
    a.w_cv = (const float*)d_in[15]; a.w_co = (const float*)d_in[16]; a.norm_ffn = (const float*)d_in[17]; a.w_router = (const float*)d_in[18]; a.b_router = (const float*)d_in[19];
    a.w_gu = (const float*)d_in[20]; a.b_gu = (const float*)d_in[21]; a.w_down = (const float*)d_in[22]; a.b_down = (const float*)d_in[23]; a.norm_final = (const float*)d_in[24];
    a.out = (float*)d_out; a.ws = (unsigned char*)d_ws; a.pad = 0;
#if MK_ONE_LAUNCH
    a.ph_lo = 0; a.ph_hi = N_PHASES; a.use_bar = 1;
    hipLaunchKernelGGL(fwd_kernel, dim3(grid), dim3(NTHREADS), LDS_BYTES, stream, a);
#else
    for (int p = 0; p < N_PHASES; ++p) { a.ph_lo = p; a.ph_hi = p + 1; a.use_bar = 0; const int reps = ((REP_MASK >> p) & 1) ? 2 : 1;
        for (int r = 0; r < reps; ++r) hipLaunchKernelGGL(fwd_kernel, dim3(grid), dim3(NTHREADS), LDS_BYTES, stream, a); }
#endif
}
```
